# Optimizing an MI355X kernel written in HIP

```python
import jax, jax.numpy as jnp
from jax import lax
import numpy as np

D_MODEL = 1024
BATCH = 8
SEQ = 2048
DEPTH = 4
DEC_BATCH = 128
DEC_SEQ = 1
PAST_LEN = 16384
PAGE_SIZE = 128

N_EVEN = (DEPTH + 1) // 2
N_ODD = DEPTH // 2
MIX_A = D_MODEL // 2
MIX_B = D_MODEL - MIX_A
HG_HEAD_DIM = 128
HG_HEADS = MIX_A // HG_HEAD_DIM
GDN_HEAD_DIM = 128
GDN_HEADS = MIX_B // GDN_HEAD_DIM
GDN_CONV = 4
POOL_WINDOWS = (2, 4, 8, 16)
POOL_GROUPS = len(POOL_WINDOWS)
POOL_GROUP_DIM = D_MODEL // POOL_GROUPS
POOL_BUF = max(POOL_WINDOWS) - 1
D_FF = ((8 * D_MODEL // 3 + 127) // 128) * 128
IN_EVEN = 4 * MIX_A + 4 * MIX_B + 2 * GDN_HEADS
HG_CHUNK = 32
GDN_CHUNK = 64
EPS = 1e-6

kernel_name = 'hybrid_hgrn2_gdn_pool_decoder_step'


def rmsnorm(x, w):
    xf = x.astype(jnp.float32)
    y = xf * lax.rsqrt(jnp.mean(xf * xf, axis=-1, keepdims=True) + EPS)
    return (y * w.astype(jnp.float32)).astype(x.dtype)


def l2norm(t):
    return t * lax.rsqrt(jnp.sum(t * t, axis=-1, keepdims=True) + EPS)


def swiglu(h, wg, wu, wd):
    return (jax.nn.silu(h @ wg) * (h @ wu)) @ wd


def _chunks(t, c):
    b, T = t.shape[:2]
    n = -(-T // c)
    t = jnp.pad(t, [(0, 0), (0, n * c - T)] + [(0, 0)] * (t.ndim - 2))
    return jnp.moveaxis(t.reshape((b, n, c) + t.shape[2:]), 1, 0)


def _unchunks(o, T):
    n, b, c = o.shape[:3]
    return jnp.moveaxis(o, 0, 1).reshape((b, n * c) + o.shape[3:])[:, :T]


def hgrn2_recurrence(q, k, v, logg, s0):
    T = q.shape[1]
    c = min(HG_CHUNK, T)
    causal = jnp.tril(jnp.ones((c, c), dtype=bool))

    def step(s, inp):
        qc, kc, vc, gc = inp
        b = jnp.cumsum(gc, axis=1)
        diff = b[:, :, None] - b[:, None, :]
        dec = jnp.exp(jnp.where(causal[None, :, :, None, None], diff, -jnp.inf))
        att = jnp.einsum('bthk,btshk,bshk->bhts', qc, dec, kc)
        o = (jnp.einsum('bhts,bshv->bthv', att, vc)
             + jnp.einsum('bthk,bhkv->bthv', qc * jnp.exp(b), s))
        bl = b[:, -1]
        s = (jnp.exp(bl)[..., None] * s
             + jnp.einsum('bshk,bshv->bhkv', kc * jnp.exp(bl[:, None] - b), vc))
        return s, o

    xs = (_chunks(q, c), _chunks(k, c), _chunks(v, c), _chunks(logg, c))
    s, o = lax.scan(step, s0, xs)
    return _unchunks(o, T), s


def gated_delta_recurrence(q, k, v, g, beta, s0):
    T = q.shape[1]
    c = min(GDN_CHUNK, T)
    dv = v.shape[-1]
    incl = jnp.tril(jnp.ones((c, c), dtype=bool))
    strict = jnp.tril(jnp.ones((c, c), dtype=bool), -1)
    eye = jnp.eye(c, dtype=jnp.float32)

    def step(s, inp):
        qc, kc, vc, gc, bc = inp
        b = jnp.cumsum(gc, axis=1)
        bh = jnp.swapaxes(b, 1, 2)
        diff = bh[..., :, None] - bh[..., None, :]
        L = jnp.exp(jnp.where(incl, diff, -jnp.inf))
        kb = kc * bc[..., None]
        akk = jnp.where(strict, jnp.einsum('bthk,bshk->bhts', kb, kc) * L, 0.0)
        rhs = jnp.concatenate([vc * bc[..., None], kb * jnp.exp(b)[..., None]], axis=-1)
        rhs = jnp.swapaxes(rhs, 1, 2)
        sol = lax.linalg.triangular_solve(eye + akk, rhs, left_side=True, lower=True,
                                          unit_diagonal=True)
        u, w = sol[..., :dv], sol[..., dv:]
        v_new = u - jnp.einsum('bhck,bhkv->bhcv', w, s)
        aqk = jnp.einsum('bthk,bshk->bhts', qc, kc) * L
        o = (jnp.einsum('bthk,bhkv->bhtv', qc * jnp.exp(b)[..., None], s)
             + jnp.einsum('bhts,bhsv->bhtv', aqk, v_new))
        bl = bh[..., -1]
        s = (jnp.exp(bl)[..., None, None] * s
             + jnp.einsum('bhs,bshk,bhsv->bhkv', jnp.exp(bl[..., None] - bh), kc, v_new))
        return s, jnp.swapaxes(o, 1, 2)

    xs = (_chunks(q, c), _chunks(k, c), _chunks(v, c), _chunks(g, c), _chunks(beta, c))
    s, o = lax.scan(step, s0, xs)
    return _unchunks(o, T), s


def even_mixer(h, s_hg, s_gdn, conv_buf, lb, w_in, hg_norm_w, conv_w, a_log, dt_bias,
               gdn_norm_w, w_out):
    f32 = jnp.float32
    B, T, _ = h.shape
    p = h @ w_in
    sizes = (MIX_A, MIX_A, MIX_A, MIX_A, 3 * MIX_B, MIX_B, GDN_HEADS, GDN_HEADS)
    idx = np.cumsum(sizes)[:-1].tolist()
    qa, fa, ia, oga, qkv, z, a, bb = jnp.split(p, idx, axis=-1)

    def heads(t, n):
        return t.reshape(B, T, n, -1)

    lb = lb.astype(f32)
    fa32 = fa.astype(f32)
    logg = jnp.logaddexp(jnp.log(lb), jnp.log1p(-lb) + jax.nn.log_sigmoid(fa32))
    k_a = (1.0 - lb) * jax.nn.sigmoid(-fa32)
    q_a = jax.nn.silu(qa.astype(f32)) * HG_HEAD_DIM ** -0.5
    o_a, s_hg_new = hgrn2_recurrence(heads(q_a, HG_HEADS), heads(k_a, HG_HEADS),
                                     heads(ia.astype(f32), HG_HEADS), heads(logg, HG_HEADS),
                                     s_hg.astype(f32))
    o_a = rmsnorm(o_a, hg_norm_w) * jax.nn.sigmoid(heads(oga.astype(f32), HG_HEADS))

    ext = jnp.concatenate([conv_buf.astype(qkv.dtype), qkv], axis=1)
    conv = lax.conv_general_dilated(ext, conv_w.astype(ext.dtype)[:, None, :], (1,), 'VALID',
                                    dimension_numbers=('NWC', 'WIO', 'NWC'),
                                    feature_group_count=3 * MIX_B)
    conv = jax.nn.silu(conv.astype(f32))
    qb, kb, vb = jnp.split(conv, 3, axis=-1)
    qb = l2norm(heads(qb, GDN_HEADS)) * GDN_HEAD_DIM ** -0.5
    kb = l2norm(heads(kb, GDN_HEADS))
    g = -jnp.exp(a_log.astype(f32)) * jax.nn.softplus(a.astype(f32) + dt_bias.astype(f32))
    beta = jax.nn.sigmoid(bb.astype(f32))
    o_b, s_gdn_new = gated_delta_recurrence(qb, kb, heads(vb, GDN_HEADS), g, beta,
                                            s_gdn.astype(f32))
    o_b = rmsnorm(o_b, gdn_norm_w) * jax.nn.silu(heads(z.astype(f32), GDN_HEADS))

    o = jnp.concatenate([o_a.reshape(B, T, MIX_A), o_b.reshape(B, T, MIX_B)], axis=-1)
    y = o.astype(h.dtype) @ w_out
    return (y, s_hg_new.astype(s_hg.dtype), s_gdn_new.astype(s_gdn.dtype),
            ext[:, -(GDN_CONV - 1):].astype(conv_buf.dtype))


def pool_mixer(h, buf, pos0, w_in, w_grp, scale):
    f32 = jnp.float32
    B, T, _ = h.shape
    u = h @ w_in
    ext = jnp.concatenate([buf.astype(u.dtype), u], axis=1)
    cs = jnp.pad(jnp.cumsum(ext.astype(f32), axis=1), ((0, 0), (1, 0), (0, 0)))
    pos = pos0 + jnp.arange(T)
    o0 = POOL_BUF + 1
    diffs = []
    for gi, w in enumerate(POOL_WINDOWS):
        sl = slice(gi * POOL_GROUP_DIM, (gi + 1) * POOL_GROUP_DIM)
        win = cs[:, o0:o0 + T, sl] - cs[:, o0 - w:o0 - w + T, sl]
        cnt = jnp.minimum(pos + 1, w).astype(f32)[None, :, None]
        diffs.append(win / cnt - u[..., sl].astype(f32))
    d = jnp.stack(diffs, axis=2)
    y = jnp.einsum('btgc,gcd->btgd', d, w_grp.astype(f32)).reshape(B, T, D_MODEL)
    y = y * scale.astype(f32)
    return y.astype(h.dtype), ext[:, -POOL_BUF:].astype(buf.dtype)


def trunk(x, s_hg, s_gdn, s_conv, s_pool, pos0, prm):
    lb_all = jnp.cumsum(jax.nn.softmax(prm['hgrn_lb'].astype(jnp.float32), axis=0), axis=0)
    lb_all = lb_all - lb_all[:1]
    new_hg, new_gdn, new_conv, new_pool = [], [], [], []
    for li in range(DEPTH):
        x = x + 0.5 * swiglu(rmsnorm(x, prm['norm_ffn1'][li]), prm['ffn1_w_gate'][li],
                             prm['ffn1_w_up'][li], prm['ffn1_w_down'][li])
        h = rmsnorm(x, prm['norm_mix'][li])
        if li % 2 == 0:
            e = li // 2
            y, a, b, c = even_mixer(h, s_hg[e], s_gdn[e], s_conv[e], lb_all[e],
                                    prm['w_in_even'][e], prm['hgrn_norm_w'][e],
                                    prm['gdn_conv_w'][e], prm['gdn_a_log'][e],
                                    prm['gdn_dt_bias'][e], prm['gdn_norm_w'][e],
                                    prm['w_out_even'][e])
            new_hg.append(a)
            new_gdn.append(b)
            new_conv.append(c)
        else:
            o = li // 2
            y, pb = pool_mixer(h, s_pool[o], pos0, prm['pool_w_in'][o], prm['pool_w_group'][o],
                               prm['pool_scale'][o])
            new_pool.append(pb)
        x = x + y
        x = x + 0.5 * swiglu(rmsnorm(x, prm['norm_ffn2'][li]), prm['ffn2_w_gate'][li],
                             prm['ffn2_w_up'][li], prm['ffn2_w_down'][li])
    y = rmsnorm(x, prm['final_norm'])
    return y, jnp.stack(new_hg), jnp.stack(new_gdn), jnp.stack(new_conv), jnp.stack(new_pool)


def setup_inputs(seed: int = 0) -> dict:
    key = jax.random.key(seed)
    ks = jax.random.split(key, 32)
    f32 = jnp.float32

    def nrm(i, shape, s):
        return jax.random.normal(ks[i], shape, f32) * s

    dt = jnp.exp(jax.random.uniform(ks[10], (N_EVEN, GDN_HEADS), f32,
                                    np.log(1e-3).astype(np.float32), np.log(1e-1).astype(np.float32)))
    return {
        'x_prompt': nrm(0, (BATCH, SEQ, D_MODEL), 1.0),
        'x_sample': nrm(1, (DEC_BATCH, DEC_SEQ, D_MODEL), 1.0),
        'state_hgrn': nrm(2, (N_EVEN, DEC_BATCH, HG_HEADS, HG_HEAD_DIM, HG_HEAD_DIM), 0.5),
        'state_gdn': nrm(3, (N_EVEN, DEC_BATCH, GDN_HEADS, GDN_HEAD_DIM, GDN_HEAD_DIM), 0.1),
        'state_gdn_conv': nrm(4, (N_EVEN, DEC_BATCH, GDN_CONV - 1, 3 * MIX_B), 1.0),
        'state_pool': nrm(5, (N_ODD, DEC_BATCH, POOL_BUF, D_MODEL), 1.0),
        'hgrn_lb': 1.0 + nrm(6, (N_EVEN, MIX_A), 0.1),
        'w_in_even': nrm(7, (N_EVEN, D_MODEL, IN_EVEN), D_MODEL ** -0.5),
        'hgrn_norm_w': 1.0 + nrm(8, (N_EVEN, HG_HEAD_DIM), 0.05),
        'gdn_conv_w': nrm(9, (N_EVEN, GDN_CONV, 3 * MIX_B), 0.5),
        'gdn_a_log': jnp.log(jax.random.uniform(ks[11], (N_EVEN, GDN_HEADS), f32, 1.0, 16.0)),
        'gdn_dt_bias': dt + jnp.log(-jnp.expm1(-dt)),
        'gdn_norm_w': 1.0 + nrm(12, (N_EVEN, GDN_HEAD_DIM), 0.05),
        'w_out_even': nrm(13, (N_EVEN, D_MODEL, D_MODEL), D_MODEL ** -0.5),
        'pool_w_in': nrm(14, (N_ODD, D_MODEL, D_MODEL), D_MODEL ** -0.5),
        'pool_w_group': nrm(15, (N_ODD, POOL_GROUPS, POOL_GROUP_DIM, POOL_GROUP_DIM),
                            POOL_GROUP_DIM ** -0.5),
        'pool_scale': 1.0 + nrm(16, (N_ODD, D_MODEL), 0.1),
        'norm_ffn1': 1.0 + nrm(17, (DEPTH, D_MODEL), 0.05),
        'ffn1_w_gate': nrm(18, (DEPTH, D_MODEL, D_FF), D_MODEL ** -0.5),
        'ffn1_w_up': nrm(19, (DEPTH, D_MODEL, D_FF), D_MODEL ** -0.5),
        'ffn1_w_down': nrm(20, (DEPTH, D_FF, D_MODEL), D_FF ** -0.5),
        'norm_mix': 1.0 + nrm(21, (DEPTH, D_MODEL), 0.05),
        'norm_ffn2': 1.0 + nrm(22, (DEPTH, D_MODEL), 0.05),
        'ffn2_w_gate': nrm(23, (DEPTH, D_MODEL, D_FF), D_MODEL ** -0.5),
        'ffn2_w_up': nrm(24, (DEPTH, D_MODEL, D_FF), D_MODEL ** -0.5),
        'ffn2_w_down': nrm(25, (DEPTH, D_FF, D_MODEL), D_FF ** -0.5),
        'final_norm': 1.0 + nrm(26, (D_MODEL,), 0.05),
    }


def reference(x_prompt, x_sample, state_hgrn, state_gdn, state_gdn_conv, state_pool,
              hgrn_lb, w_in_even, hgrn_norm_w, gdn_conv_w, gdn_a_log, gdn_dt_bias, gdn_norm_w,
              w_out_even, pool_w_in, pool_w_group, pool_scale, norm_ffn1, ffn1_w_gate, ffn1_w_up,
              ffn1_w_down, norm_mix, norm_ffn2, ffn2_w_gate, ffn2_w_up, ffn2_w_down, final_norm):
    prm = dict(hgrn_lb=hgrn_lb, w_in_even=w_in_even, hgrn_norm_w=hgrn_norm_w,
               gdn_conv_w=gdn_conv_w, gdn_a_log=gdn_a_log, gdn_dt_bias=gdn_dt_bias,
               gdn_norm_w=gdn_norm_w, w_out_even=w_out_even, pool_w_in=pool_w_in,
               pool_w_group=pool_w_group, pool_scale=pool_scale, norm_ffn1=norm_ffn1,
               ffn1_w_gate=ffn1_w_gate, ffn1_w_up=ffn1_w_up, ffn1_w_down=ffn1_w_down,
               norm_mix=norm_mix, norm_ffn2=norm_ffn2, ffn2_w_gate=ffn2_w_gate,
               ffn2_w_up=ffn2_w_up, ffn2_w_down=ffn2_w_down, final_norm=final_norm)
    bp = x_prompt.shape[0]
    z_hg = jnp.zeros((N_EVEN, bp) + state_hgrn.shape[2:], state_hgrn.dtype)
    z_gdn = jnp.zeros((N_EVEN, bp) + state_gdn.shape[2:], state_gdn.dtype)
    z_conv = jnp.zeros((N_EVEN, bp) + state_gdn_conv.shape[2:], state_gdn_conv.dtype)
    z_pool = jnp.zeros((N_ODD, bp) + state_pool.shape[2:], state_pool.dtype)
    y_prompt, hg_p, gdn_p, conv_p, pool_p = trunk(x_prompt, z_hg, z_gdn, z_conv, z_pool, 0, prm)
    y_sample, hg_s, gdn_s, conv_s, pool_s = trunk(x_sample, state_hgrn, state_gdn, state_gdn_conv,
                                                  state_pool, PAST_LEN, prm)
    return (y_prompt, y_sample, hg_p, gdn_p, conv_p, pool_p, hg_s, gdn_s, conv_s, pool_s)
```

```cpp
#include <hip/hip_runtime.h>
#include <hip/hip_cooperative_groups.h>
#include <cstdio>
namespace cg = cooperative_groups;


#define LAS __attribute__((address_space(3)))
typedef unsigned short bf16_t;
typedef short bf16x8 __attribute__((ext_vector_type(8)));
typedef float f32x4 __attribute__((ext_vector_type(4)));
typedef unsigned u32x4 __attribute__((ext_vector_type(4)));
typedef unsigned u32x2 __attribute__((ext_vector_type(2)));
typedef unsigned long long u64;
#define SS_RS(v) rsqrtf((float)(v) * (1.f / (16777216.f * 1024.f)) + EPS)

constexpr int D = 1024, FF = 2816, TP = 2048, NB = 8, MP = 16384, MS = 128, MR = 16512, M = 16640;
constexpr int NMT = M / 256;
constexpr float EPS = 1e-6f;
constexpr int NPH = 32;
constexpr int LDS_BYTES = 131072 + 16;

constexpr size_t SZ_WGU = (size_t)5632 * 1024 * 2, SZ_WD = (size_t)1024 * 2816 * 2, SZ_WIN = (size_t)4096 * 1024 * 2, SZ_W1K = (size_t)1024 * 1024 * 2, SZ_WGRP = (size_t)1024 * 256 * 2;
constexpr size_t WS_WGU = 0;
constexpr size_t WS_WD = WS_WGU + 8 * SZ_WGU;
constexpr size_t WS_WIN = WS_WD + 8 * SZ_WD;
constexpr size_t WS_WOUT = WS_WIN + 2 * SZ_WIN;
constexpr size_t WS_WP = WS_WOUT + 2 * SZ_W1K;
constexpr size_t WS_WGRP = WS_WP + 2 * SZ_W1K;
constexpr size_t WS_WAB = WS_WGRP + 2 * SZ_WGRP;
constexpr size_t WS_XB = WS_WAB + 2 * 8 * 1024 * 4;
constexpr size_t WS_SS = WS_XB + (size_t)M * 1024 * 2;
constexpr size_t WS_AB = WS_SS + (size_t)13 * M * 8;
constexpr size_t WS_OA = WS_AB + (size_t)M * 8 * 4;
constexpr size_t WS_LOGG = WS_OA + (size_t)M * 1024 * 2;
constexpr size_t WS_P16 = WS_LOGG + (size_t)M * 512 * 4;
constexpr size_t E2G_BYTES = 73984, E2H_BYTES = 57856;
constexpr size_t WS_E2G = WS_P16 + (size_t)M * 4096 * 2;
constexpr size_t WS_E2H = WS_E2G + 1024 * E2G_BYTES;
constexpr size_t WS_END = WS_E2H + 1024 * E2H_BYTES;

constexpr size_t O_Y = 0, O_HGP = 16908288, O_GDP = 17956864, O_CVP = 19005440, O_PLP = 19079168, O_HGS = 19324928, O_GDS = 36102144, O_CVS = 52879360, O_PLS = 54059008;

struct Params {
    const float* in[27];
    float* out;
    unsigned char* ws;
    int ph_lo, ph_hi;
};

typedef __bf16 bf16x2_t __attribute__((ext_vector_type(2)));
typedef float f32x2_t __attribute__((ext_vector_type(2)));
__device__ __forceinline__ unsigned pk2(float lo, float hi) { f32x2_t v = {lo, hi}; bf16x2_t b = __builtin_convertvector(v, bf16x2_t); return __builtin_bit_cast(unsigned, b); }
__device__ __forceinline__ bf16_t f2bf(float f) { return (bf16_t)(pk2(f, 0.f) & 0xffffu); }
__device__ __forceinline__ float bf2f(bf16_t b) { return __uint_as_float(((unsigned)b) << 16); }
__device__ __forceinline__ float bflo(unsigned w) { return __uint_as_float(w << 16); }
__device__ __forceinline__ float bfhi(unsigned w) { return __uint_as_float(w & 0xffff0000u); }
__device__ __forceinline__ float sigm(float x) { return __builtin_amdgcn_rcpf(1.f + __expf(-x)); }
__device__ __forceinline__ float silu(float x) { return x * sigm(x); }
__device__ __forceinline__ void unpack8(u32x4 a, float* x) { x[0] = bflo(a.x); x[1] = bfhi(a.x); x[2] = bflo(a.y); x[3] = bfhi(a.y); x[4] = bflo(a.z); x[5] = bfhi(a.z); x[6] = bflo(a.w); x[7] = bfhi(a.w); }
__device__ __forceinline__ u32x4 pack8(const float* x) { u32x4 r; r.x = pk2(x[0], x[1]); r.y = pk2(x[2], x[3]); r.z = pk2(x[4], x[5]); r.w = pk2(x[6], x[7]); return r; }
__device__ __forceinline__ float wave_sum(float v) {
#pragma unroll
    for (int o = 1; o < 64; o <<= 1) v += __shfl_xor(v, o);
    return v;
}
#define LDS_WAIT() asm volatile("s_waitcnt lgkmcnt(0)" ::: "memory")
__device__ __forceinline__ int fo_off(int R, int C, int KS) { return ((((R >> 4) * KS + (C >> 5)) * 64 + ((C >> 3) & 3) * 16 + (R & 15)) << 3) + (C & 7); }
__device__ __forceinline__ f32x4 mfma16(bf16x8 a, bf16x8 b, f32x4 c) { return __builtin_amdgcn_mfma_f32_16x16x32_bf16(a, b, c, 0, 0, 0); }

namespace pg8 {
constexpr int BM = 256, BK = 64, HALF = 128, HTB = HALF * BK * 2, NXCD = 8, WGM = 8;
__device__ __forceinline__ int lds_byte(int r, int c) { const int st = (r >> 4) * 2 + (c >> 5), rr = r & 15, cc = c & 31, ob = rr * 64 + cc * 2; return st * 1024 + (ob ^ (((ob >> 9) & 1) << 5)); }
__device__ __forceinline__ void stage_rc(int b, int& R, int& C) { const int st = b / 1024, sb = b % 1024, swz = sb ^ (((sb >> 9) & 1) << 5); R = (st >> 1) * 16 + swz / 64; C = (st & 1) * 32 + (swz % 64) / 2; }
__device__ __forceinline__ int perm32(int rho) { const int n = rho >> 4, i = rho & 15; return 8 * (i >> 2) + 4 * n + (i & 3); }
struct Unit { int pm, pn; };
struct Gemm { const bf16_t* A; const bf16_t* Bt; int nM, nN, K, lda, apn, ldb, nNr, pm0; };
struct StaticOrder {
    int nM, nN, nwg, G, c, mode;
    __device__ void init(int nM_, int nN_, int G_, int c_) { nM = nM_; nN = nN_; nwg = nM * nN; G = G_; c = c_; mode = 0; }
    __device__ void init_f1(int c_) { nM = 64; nN = 22; nwg = 1408; G = 256; c = c_; mode = 1; }
    __device__ bool next(int i, Unit& u) const {
        long L = (long)i * G + c;
        if (mode == 1) {
            if (c >= 248) { if (i >= 4) return false; }
            else if (c >= 150 && c < 158) { if (i == 5) L = 1024 + (c + 98); else if (i > 5) return false; }
            else if (L >= 1430) return false;
            if (L < 22) { u.pm = 64; u.pn = (int)L; return true; }
            L -= 22;
        }
        if (L >= nwg) return false;
        int wgid = (int)L; { const int q = nwg / NXCD, r = nwg % NXCD, xcd = wgid % NXCD, off = wgid / NXCD; wgid = (xcd < r ? xcd * (q + 1) : r * (q + 1) + (xcd - r) * q) + off; }
        const int nig = WGM * nN, gid = wgid / nig, fm = gid * WGM, gsz = (nM - fm) < WGM ? (nM - fm) : WGM;
        u.pm = fm + ((wgid % nig) % gsz); u.pn = (wgid % nig) / gsz; return true;
    }
};

template <class Epi>
__device__ __forceinline__ void gemm_phase(LAS unsigned char* lds, const Gemm g, const StaticOrder& S, const Epi& E) {
    int tid_ = threadIdx.x; asm volatile("" : "+v"(tid_));
    const int tid = tid_, wid = __builtin_amdgcn_readfirstlane(tid >> 6), lane = tid & 63, wr = wid >> 2, wc = wid & 3, fr = lane & 15, fq = lane >> 4;
    const int K = g.K, nt = K / BK;
    unsigned voffA[2], voffB[2];
#pragma unroll
    for (int i = 0; i < 2; ++i) { int R, C; stage_rc(tid * 16 + i * 8192, R, C); const int Rb = Epi::PERM ? ((R & ~31) + perm32(R & 31)) : R;
        voffA[i] = (unsigned)(R * g.lda + C) * 2u; voffB[i] = (unsigned)(Rb * g.ldb + C) * 2u; }
    const size_t kstep = (size_t)(BK * 2);
    const size_t hstepA = (size_t)HALF * g.lda * 2, hstepB = (size_t)HALF * g.ldb * 2;
    const size_t tstepA = 2 * hstepA, tstepB = 2 * hstepB;
    const unsigned ldsw = (unsigned)wid * 1024u;
    const int aoff = lds_byte(wr * 64 + fr, fq * 8), boff = lds_byte(wc * 32 + fr, fq * 8);
#define PG8_SA(b, h) (((b) * 2 + (h)) * HTB)
#define PG8_SB(b, h) ((4 + (b) * 2 + (h)) * HTB)
#define PG8_STAGE(bufoff, gbase, voff) do { _Pragma("unroll") for (int _i = 0; _i < 2; ++_i) \
        __builtin_amdgcn_global_load_lds((const unsigned*)((const char*)(gbase) + (voff)[_i]), (LAS unsigned*)(lds + (bufoff) + ldsw + _i * 8192), 16, 0, 0); } while (0)
#define PG8_LDA(dst, b, h) do { _Pragma("unroll") for (int m = 0; m < 4; ++m) _Pragma("unroll") for (int k = 0; k < 2; ++k) dst[m][k] = *(const LAS bf16x8*)(lds + PG8_SA(b, h) + aoff + m * 2048 + k * 1024); } while (0)
#define PG8_LDB(dst, b, h) do { _Pragma("unroll") for (int n = 0; n < 2; ++n) _Pragma("unroll") for (int k = 0; k < 2; ++k) dst[n][k] = *(const LAS bf16x8*)(lds + PG8_SB(b, h) + boff + n * 2048 + k * 1024); } while (0)
#define PG8_MMA(ai, bj, At, Bt) do { __builtin_amdgcn_s_setprio(1); _Pragma("unroll") for (int m = 0; m < 4; ++m) _Pragma("unroll") for (int n = 0; n < 2; ++n) _Pragma("unroll") for (int k = 0; k < 2; ++k) \
        acc[ai][bj][m][n] = __builtin_amdgcn_mfma_f32_16x16x32_bf16(Bt[n][k], At[m][k], acc[ai][bj][m][n], 0, 0, 0); __builtin_amdgcn_s_setprio(0); } while (0)
#define PG8_WAIT_V(n) asm volatile("s_waitcnt vmcnt(" #n ")" ::: "memory")
#define PG8_WAIT_L(n) asm volatile("s_waitcnt lgkmcnt(" #n ")" ::: "memory")
#define PG8_BAR __builtin_amdgcn_s_barrier()
#define PG8_SCHED __builtin_amdgcn_sched_barrier(0)
    Unit cur, nxt; int ui = 0;
    if (!S.next(0, cur)) return;
    f32x4 acc[2][2][4][2];
#pragma unroll
    for (int a = 0; a < 2; ++a)
#pragma unroll
        for (int b = 0; b < 2; ++b)
#pragma unroll
            for (int m = 0; m < 4; ++m)
#pragma unroll
                for (int n = 0; n < 2; ++n) acc[a][b][m][n] = (f32x4){0.f, 0.f, 0.f, 0.f};
    bf16x8 At[4][2], B0[2][2], B1[2][2];
#define PG8_ABASE(u) ((const char*)g.A + (size_t)((u).pm + g.pm0) * tstepA + ((size_t)((u).pn % g.nNr) * g.apn + (size_t)((u).pn / g.nNr) * K) * 2)
#define PG8_BBASE(u) ((const char*)g.Bt + (size_t)((u).pn % g.nNr) * tstepB + (size_t)((u).pn / g.nNr) * K * 2)
    const char* cA = PG8_ABASE(cur); const char* cB = PG8_BBASE(cur);
    PG8_STAGE(PG8_SB(0, 0), cB, voffB); PG8_STAGE(PG8_SA(0, 0), cA, voffA); PG8_STAGE(PG8_SB(0, 1), cB + hstepB, voffB); PG8_STAGE(PG8_SA(0, 1), cA + hstepA, voffA);
    if (wr == 1) PG8_BAR;
    PG8_WAIT_V(4); PG8_BAR;
    PG8_STAGE(PG8_SB(1, 0), cB + kstep, voffB); PG8_STAGE(PG8_SA(1, 0), cA + kstep, voffA); PG8_STAGE(PG8_SB(1, 1), cB + hstepB + kstep, voffB);
    PG8_WAIT_V(6); PG8_BAR;
    for (;;) {
        const bool has_next = S.next(ui + 1, nxt);
        const char* nA = has_next ? PG8_ABASE(nxt) : cA; const char* nB = has_next ? PG8_BBASE(nxt) : cB;
        for (int t = 0; t < nt; t += 2) {
            const bool last = (t == nt - 2);
            const char* a1 = cA + (size_t)(t + 1) * kstep;
            const char* a2 = last ? nA : cA + (size_t)(t + 2) * kstep; const char* b2 = last ? nB : cB + (size_t)(t + 2) * kstep;
            const char* a3 = a2 + kstep; const char* b3 = b2 + kstep;
            PG8_LDB(B0, 0, 0); PG8_SCHED; PG8_LDA(At, 0, 0); PG8_STAGE(PG8_SA(1, 1), a1 + hstepA, voffA);
            PG8_WAIT_L(8); PG8_BAR; PG8_WAIT_L(0); PG8_MMA(0, 0, At, B0); PG8_BAR; PG8_SCHED;
            PG8_LDB(B1, 0, 1); PG8_STAGE(PG8_SB(0, 0), b2, voffB);
            PG8_BAR; PG8_WAIT_L(0); PG8_MMA(0, 1, At, B1); PG8_BAR;
            PG8_LDA(At, 0, 1); PG8_STAGE(PG8_SA(0, 0), a2, voffA);
            PG8_BAR; PG8_WAIT_L(0); PG8_MMA(1, 0, At, B0); PG8_BAR; PG8_SCHED;
            PG8_STAGE(PG8_SB(0, 1), b2 + hstepB, voffB);
            PG8_WAIT_V(6); PG8_BAR; PG8_MMA(1, 1, At, B1); PG8_BAR;
            PG8_LDB(B0, 1, 0); PG8_SCHED; PG8_LDA(At, 1, 0); PG8_STAGE(PG8_SA(0, 1), a2 + hstepA, voffA);
            PG8_WAIT_L(8); PG8_BAR; PG8_WAIT_L(0); PG8_MMA(0, 0, At, B0); PG8_BAR; PG8_SCHED;
            PG8_LDB(B1, 1, 1); PG8_STAGE(PG8_SB(1, 0), b3, voffB);
            PG8_BAR; PG8_WAIT_L(0); PG8_MMA(0, 1, At, B1); PG8_BAR;
            PG8_LDA(At, 1, 1); PG8_STAGE(PG8_SA(1, 0), a3, voffA);
            PG8_BAR; PG8_WAIT_L(0); PG8_MMA(1, 0, At, B0); PG8_BAR; PG8_SCHED;
            PG8_STAGE(PG8_SB(1, 1), b3 + hstepB, voffB);
            PG8_WAIT_V(6); PG8_BAR; PG8_MMA(1, 1, At, B1); PG8_BAR;
        }
        { Unit eu; eu.pm = cur.pm + g.pm0; eu.pn = cur.pn; E(acc, eu, wr, wc, fr, fq); }
        if (!has_next) break;
#pragma unroll
        for (int a = 0; a < 2; ++a)
#pragma unroll
            for (int b = 0; b < 2; ++b)
#pragma unroll
                for (int m = 0; m < 4; ++m)
#pragma unroll
                    for (int n = 0; n < 2; ++n) acc[a][b][m][n] = (f32x4){0.f, 0.f, 0.f, 0.f};
        cur = nxt; cA = nA; cB = nB; ++ui;
    }
    PG8_WAIT_V(0);
    if (wr == 0) PG8_BAR;
    PG8_BAR;
#undef PG8_ABASE
#undef PG8_BBASE
#undef PG8_SA
#undef PG8_SB
#undef PG8_STAGE
#undef PG8_LDA
#undef PG8_LDB
#undef PG8_MMA
#undef PG8_WAIT_V
#undef PG8_WAIT_L
#undef PG8_BAR
#undef PG8_SCHED
}

struct EpiGU {
    static constexpr bool PERM = true;
    bf16_t* ACT; const u64* ss; unsigned* cnt;
    __device__ __forceinline__ void operator()(const f32x4 (&acc)[2][2][4][2], const Unit& u, int wr, int wc, int fr, int fq) const {
        const int row0 = u.pm * BM + wr * 64 + fr, col0 = u.pn * 128 + wc * 32 + 8 * fq;
        if (cnt && u.pm == 64) {
            const __amdgpu_buffer_rsrc_t rsrc = __builtin_amdgcn_make_buffer_rsrc(ACT, 0, M * FF * 2, 0x00020000);
#pragma unroll
            for (int m = 0; m < 4; ++m) {
                const int r = row0 + m * 16; const float rs = SS_RS(ss[r]);
                float o[8];
#pragma unroll
                for (int n = 0; n < 2; ++n)
#pragma unroll
                    for (int j = 0; j < 4; ++j) { const float gg = acc[0][0][m][n][j] * rs, uu = acc[0][1][m][n][j] * rs; o[4 * n + j] = silu(gg) * uu; }
                __builtin_amdgcn_raw_buffer_store_b128(pack8(o), rsrc, (unsigned)(((size_t)r * FF + col0) * 2), 0, 16);
            }
            asm volatile("s_waitcnt vmcnt(0)" ::: "memory");
            if (fr == 0 && fq == 0) (void)__hip_atomic_fetch_add(cnt, 1u, __ATOMIC_RELAXED, __HIP_MEMORY_SCOPE_AGENT);
            return;
        }
        u64 sv[2][4]; float rsv[2][4];
#pragma unroll
        for (int ai = 0; ai < 2; ++ai)
#pragma unroll
            for (int m = 0; m < 4; ++m) sv[ai][m] = ss[row0 + ai * HALF + m * 16];
#pragma unroll
        for (int ai = 0; ai < 2; ++ai)
#pragma unroll
            for (int m = 0; m < 4; ++m) rsv[ai][m] = SS_RS(sv[ai][m]);
#pragma unroll
        for (int ai = 0; ai < 2; ++ai)
#pragma unroll
            for (int m = 0; m < 4; ++m) {
                const int r = row0 + ai * HALF + m * 16; const float rs = rsv[ai][m];
                float o[8];
#pragma unroll
                for (int n = 0; n < 2; ++n)
#pragma unroll
                    for (int j = 0; j < 4; ++j) { const float gg = acc[ai][0][m][n][j] * rs, uu = acc[ai][1][m][n][j] * rs; o[4 * n + j] = silu(gg) * uu; }
                *(u32x4*)(ACT + (size_t)r * FF + col0) = pack8(o);
            }
    }
};
struct EpiX {
    static constexpr bool PERM = true;
    float* X; bf16_t* XB; u64* ssn; const float* scale; float alpha;
    __device__ __forceinline__ void operator()(const f32x4 (&acc)[2][2][4][2], const Unit& u, int wr, int wc, int fr, int fq) const {
        const int row0 = u.pm * BM + wr * 64 + fr, col0 = u.pn * BM + wc * 32 + 8 * fq;
#pragma unroll
        for (int ai = 0; ai < 2; ++ai)
#pragma unroll
            for (int mp = 0; mp < 4; mp += 2) {
                f32x4 xv[2][2][2];
#pragma unroll
                for (int mm = 0; mm < 2; ++mm)
#pragma unroll
                    for (int bj = 0; bj < 2; ++bj) { const float* xp = X + (size_t)(row0 + ai * HALF + (mp + mm) * 16) * D + col0 + bj * HALF; xv[mm][bj][0] = *(const f32x4*)xp; xv[mm][bj][1] = *(const f32x4*)(xp + 4); }
#pragma unroll
                for (int mm = 0; mm < 2; ++mm) {
                    const int m = mp + mm;
                    const int r = row0 + ai * HALF + m * 16; const bool ok = r < MR; float sq = 0.f;
#pragma unroll
                    for (int bj = 0; bj < 2; ++bj) {
                        const int c = col0 + bj * HALF; float* xp = X + (size_t)r * D + c;
                        f32x4 y0 = acc[ai][bj][m][0] * alpha, y1 = acc[ai][bj][m][1] * alpha;
                        if (scale) { y0 = y0 * *(const f32x4*)(scale + c); y1 = y1 * *(const f32x4*)(scale + c + 4); }
                        const f32x4 x0 = xv[mm][bj][0] + y0, x1 = xv[mm][bj][1] + y1;
                        if (ok) {
                            *(f32x4*)xp = x0; *(f32x4*)(xp + 4) = x1;
                            u32x4 w; w.x = pk2(x0.x, x0.y); w.y = pk2(x0.z, x0.w); w.z = pk2(x1.x, x1.y); w.w = pk2(x1.z, x1.w);
                            *(u32x4*)(XB + (size_t)r * D + c) = w;
                            sq += (x0.x * x0.x + x0.y * x0.y) + (x0.z * x0.z + x0.w * x0.w) + (x1.x * x1.x + x1.y * x1.y) + (x1.z * x1.z + x1.w * x1.w);
                        }
                    }
                    sq += __shfl_xor(sq, 16); sq += __shfl_xor(sq, 32);
                    if (ok && fq == 0) atomicAdd(ssn + r, (u64)(sq * 16777216.f + 0.5f));
                }
            }
    }
};
struct EpiSplitX {
    static constexpr bool PERM = true;
    EpiX inner; float* part; unsigned* tick; int nNr;
    __device__ __forceinline__ void operator()(const f32x4 (&acc)[2][2][4][2], const Unit& u, int wr, int wc, int fr, int fq) const {
        const int pn_r = u.pn % nNr, ks = u.pn / nNr, wave = wr * 4 + wc, lane = fq * 16 + fr;
        const __amdgpu_buffer_rsrc_t rsrc = __builtin_amdgcn_make_buffer_rsrc(part, 0, 4 * 2 * 8 * 16 * 256 * 4, 0x00020000);
        const unsigned moff = (unsigned)((((pn_r * 2 + ks) * 8 + wave) * 16) * 256 + lane * 4) * 4u;
#pragma unroll
        for (int bj = 0; bj < 2; ++bj)
#pragma unroll
            for (int m = 0; m < 4; ++m)
#pragma unroll
                for (int n = 0; n < 2; ++n) __builtin_amdgcn_raw_buffer_store_b128(__builtin_bit_cast(u32x4, acc[0][bj][m][n]), rsrc, moff + (unsigned)(((bj * 4 + m) * 2 + n) * 1024), 0, 16);
        asm volatile("s_waitcnt vmcnt(0)" ::: "memory");
        unsigned old = 0u;
        if (lane == 0) old = __hip_atomic_fetch_add(tick + pn_r * 8 + wave, 1u, __ATOMIC_RELAXED, __HIP_MEMORY_SCOPE_AGENT);
        old = (unsigned)__builtin_amdgcn_readfirstlane((int)old);
        if (old == 1u) {
            __builtin_amdgcn_fence(__ATOMIC_ACQUIRE, "agent");
            asm volatile("s_waitcnt vmcnt(0)" ::: "memory");
            const float* src = part + ((size_t)((pn_r * 2 + (ks ^ 1)) * 8 + wave) * 16) * 256 + lane * 4;
            f32x4 sum[2][2][4][2];
#pragma unroll
            for (int bj = 0; bj < 2; ++bj)
#pragma unroll
                for (int m = 0; m < 4; ++m)
#pragma unroll
                    for (int n = 0; n < 2; ++n) { sum[0][bj][m][n] = acc[0][bj][m][n] + *(const f32x4*)(src + (((bj * 4 + m) * 2 + n) * 256)); sum[1][bj][m][n] = (f32x4){0.f, 0.f, 0.f, 0.f}; }
            Unit iu; iu.pm = u.pm; iu.pn = pn_r;
            inner(sum, iu, wr, wc, fr, fq);
        }
    }
};
struct EpiP {
    static constexpr bool PERM = true;
    bf16_t* P16; float* LOGG; const u64* ss; const float* lbraw; int e;
    template <int MODE>
    __device__ __forceinline__ void run(const f32x4 (&acc)[2][2][4][2], int row0, int col0) const {
        u64 sv[2][4]; float rsv[2][4];
#pragma unroll
        for (int ai = 0; ai < 2; ++ai)
#pragma unroll
            for (int m = 0; m < 4; ++m) sv[ai][m] = ss[row0 + ai * HALF + m * 16];
#pragma unroll
        for (int ai = 0; ai < 2; ++ai)
#pragma unroll
            for (int m = 0; m < 4; ++m) rsv[ai][m] = SS_RS(sv[ai][m]);
#pragma unroll
        for (int ai = 0; ai < 2; ++ai) {
#pragma unroll
            for (int m = 0; m < 4; ++m) {
                const int r = row0 + ai * HALF + m * 16; const float rs = rsv[ai][m];
#pragma unroll
                for (int bj = 0; bj < 2; ++bj) {
                    const int c = col0 + bj * HALF; float v[8];
#pragma unroll
                    for (int n = 0; n < 2; ++n) {
#pragma unroll
                        for (int j = 0; j < 4; ++j) v[4 * n + j] = acc[ai][bj][m][n][j] * rs;
                    }
                    if (MODE == 0) {
#pragma unroll
                        for (int i = 0; i < 8; ++i) v[i] = silu(v[i]) * 0.08838834764831845f;
                    }
                    if (MODE == 1) {
                        const int ch = c - 512; float lg[8];
                        const f32x4 l0a = *(const f32x4*)(lbraw + ch), l0b = *(const f32x4*)(lbraw + ch + 4), l1a = *(const f32x4*)(lbraw + 512 + ch), l1b = *(const f32x4*)(lbraw + 512 + ch + 4);
                        const float dl[8] = {l0a.x - l1a.x, l0a.y - l1a.y, l0a.z - l1a.z, l0a.w - l1a.w, l0b.x - l1b.x, l0b.y - l1b.y, l0b.z - l1b.z, l0b.w - l1b.w};
#pragma unroll
                        for (int i = 0; i < 8; ++i) {
                            const float x = v[i];
                            const float lsg = fminf(x, 0.f) - __logf(1.f + __expf(-fabsf(x)));
                            const float sg = __expf(lsg);
                            const float lb = (e == 0) ? 0.f : __builtin_amdgcn_rcpf(1.f + __expf(dl[i]));
                            const float gg = lb + (1.f - lb) * sg;
                            lg[i] = (e == 0) ? lsg : __logf(gg); v[i] = 1.f - gg;
                        }
                        float* lp = LOGG + (size_t)r * 512 + ch;
                        *(f32x4*)lp = (f32x4){lg[0], lg[1], lg[2], lg[3]}; *(f32x4*)(lp + 4) = (f32x4){lg[4], lg[5], lg[6], lg[7]};
                    }
                    *(u32x4*)(P16 + (size_t)r * 4096 + c) = pack8(v);
                }
            }
        }
    }
    __device__ __forceinline__ void operator()(const f32x4 (&acc)[2][2][4][2], const Unit& u, int wr, int wc, int fr, int fq) const {
        const int row0 = u.pm * BM + wr * 64 + fr, col0 = u.pn * BM + wc * 32 + 8 * fq;
        const int region = u.pn >> 1;
        if (region == 0) run<0>(acc, row0, col0); else if (region == 1) run<1>(acc, row0, col0); else run<2>(acc, row0, col0);
    }
};
struct EpiU {
    static constexpr bool PERM = true;
    bf16_t* U; const u64* ss;
    __device__ __forceinline__ void operator()(const f32x4 (&acc)[2][2][4][2], const Unit& u, int wr, int wc, int fr, int fq) const {
        const int row0 = u.pm * BM + wr * 64 + fr, col0 = u.pn * BM + wc * 32 + 8 * fq;
        u64 sv[2][4]; float rsv[2][4];
#pragma unroll
        for (int ai = 0; ai < 2; ++ai)
#pragma unroll
            for (int m = 0; m < 4; ++m) sv[ai][m] = ss[row0 + ai * HALF + m * 16];
#pragma unroll
        for (int ai = 0; ai < 2; ++ai)
#pragma unroll
            for (int m = 0; m < 4; ++m) rsv[ai][m] = SS_RS(sv[ai][m]);
#pragma unroll
        for (int ai = 0; ai < 2; ++ai)
#pragma unroll
            for (int m = 0; m < 4; ++m) {
                const int r = row0 + ai * HALF + m * 16; const float rs = rsv[ai][m];
#pragma unroll
                for (int bj = 0; bj < 2; ++bj) {
                    float v[8];
#pragma unroll
                    for (int n = 0; n < 2; ++n)
#pragma unroll
                        for (int j = 0; j < 4; ++j) v[4 * n + j] = acc[ai][bj][m][n][j] * rs;
                    *(u32x4*)(U + (size_t)r * D + col0 + bj * HALF) = pack8(v);
                }
            }
    }
};
}

__device__ __forceinline__ void tr_item(const float* W, int ldw, const float* nw, bf16_t* WT, int ldk, int k0, int nsrc0, int rowdst0, LAS float* scr, int lane) {
#pragma unroll
    for (int i = 0; i < 32; ++i) { const int kk = 2 * i + (lane >> 5); const float s = nw ? nw[k0 + kk] : 1.f; scr[kk * 33 + (lane & 31)] = __builtin_nontemporal_load(W + (size_t)(k0 + kk) * ldw + nsrc0 + (lane & 31)) * s; }
    LDS_WAIT();
    const int c = lane & 7;
#pragma unroll
    for (int j = 0; j < 4; ++j) { const int n = (lane >> 3) + 8 * j; const LAS float* s = scr + (8 * c) * 33 + n;
        u32x4 o; o.x = pk2(s[0 * 33], s[1 * 33]); o.y = pk2(s[2 * 33], s[3 * 33]); o.z = pk2(s[4 * 33], s[5 * 33]); o.w = pk2(s[6 * 33], s[7 * 33]);
        *(u32x4*)(WT + (size_t)(rowdst0 + n) * ldk + k0 + 8 * c) = o; }
    LDS_WAIT();
}

__device__ __forceinline__ void convert_layer(const Params& p, LAS float* scr, int li, int worker, int nworkers, int lane) {
    unsigned char* ws = p.ws;
    const int nmix = (li & 1) ? 640 : 2560, total = 8448 + nmix;
    for (int it = worker; it < total; it += nworkers) {
        if (it < 8448) {
            const int idx = it / 1408, rr = it % 1408, which = idx / 3, mat = idx % 3, f = li * 2 + which;
            if (mat < 2) {
                const float* W = p.in[which ? (mat ? 24 : 23) : (mat ? 19 : 18)] + (size_t)li * D * FF;
                const float* nw = p.in[which ? 22 : 17] + li * D;
                const int kb = rr / 88, nb = rr % 88, n0 = nb * 32;
                tr_item(W, FF, nw, (bf16_t*)(ws + WS_WGU + f * SZ_WGU), D, kb * 64, n0, 256 * (n0 >> 7) + (mat ? 128 : 0) + (n0 & 127), scr, lane);
            } else {
                const float* W = p.in[which ? 25 : 20] + (size_t)li * FF * D;
                const int kb = rr / 32, nb = rr % 32;
                tr_item(W, D, nullptr, (bf16_t*)(ws + WS_WD + f * SZ_WD), FF, kb * 64, nb * 32, nb * 32, scr, lane);
            }
        } else if (!(li & 1)) {
            const int e = li >> 1; int rr = it - 8448;
            if (rr < 2048) { const int kb = rr / 128, nb = rr % 128;
                tr_item(p.in[7] + (size_t)e * D * 4104, 4104, p.in[21] + (2 * e) * D, (bf16_t*)(ws + WS_WIN + e * SZ_WIN), D, kb * 64, nb * 32, nb * 32, scr, lane);
            } else { rr -= 2048; const int kb = rr / 32, nb = rr % 32;
                tr_item(p.in[13] + (size_t)e * D * D, D, nullptr, (bf16_t*)(ws + WS_WOUT + e * SZ_W1K), D, kb * 64, nb * 32, nb * 32, scr, lane); }
        } else {
            const int o = li >> 1; int rr = it - 8448;
            if (rr < 512) { const int kb = rr / 32, nb = rr % 32;
                tr_item(p.in[14] + (size_t)o * D * D, D, p.in[21] + (2 * o + 1) * D, (bf16_t*)(ws + WS_WP + o * SZ_W1K), D, kb * 64, nb * 32, nb * 32, scr, lane);
            } else { rr -= 512; const int gq = rr / 32, r2 = rr % 32, kb = r2 / 8, nb = r2 % 8;
                tr_item(p.in[15] + (size_t)(o * 4 + gq) * 65536, 256, nullptr, (bf16_t*)(ws + WS_WGRP + o * SZ_WGRP), 256, kb * 64, nb * 32, gq * 256 + nb * 32, scr, lane); }
        }
    }
    if (!(li & 1)) {
        const int e = li >> 1; float* WAB = (float*)(ws + WS_WAB) + e * 8192;
        for (int i = worker * 64 + lane; i < 8192; i += nworkers * 64) { const int j = i >> 10, k = i & 1023; WAB[i] = p.in[7][(size_t)e * D * 4104 + (size_t)k * 4104 + 4096 + j] * p.in[21][(2 * e) * D + k]; }
    }
}

__device__ __forceinline__ void phase_prep(const Params& p, LAS unsigned char* lds) {
    int tid_ = threadIdx.x; asm volatile("" : "+v"(tid_));
    { unsigned lb_ = (unsigned)(size_t)lds; asm volatile("" : "+v"(lb_)); lds = (LAS unsigned char*)(size_t)lb_; }
    const int tid = tid_, lane = tid & 63, wave = tid >> 6;
    const int gw = blockIdx.x * 8 + wave, NGW = gridDim.x * 8;
    unsigned char* ws = p.ws;
    LAS float* scr = (LAS float*)(lds + wave * 8448);
    convert_layer(p, scr, 0, gw, NGW, lane);
    if (gridDim.x <= 64) { for (int li = 1; li < 4; ++li) convert_layer(p, scr, li, gw, NGW, lane); }
    const int gt = blockIdx.x * 512 + tid, NGT = gridDim.x * 512;
    u64* SS = (u64*)(ws + WS_SS);
    for (int i = gt; i < 12 * M; i += NGT) SS[M + i] = 0ull;
    for (int i = gt; i < M - MR; i += NGT) SS[MR + i] = 0ull;
    bf16_t* XB = (bf16_t*)(ws + WS_XB);
    for (int r = gw; r < M; r += NGW) {
        if (r < MR) {
            const float* src = (r < MP) ? p.in[0] + (size_t)r * D : p.in[1] + (size_t)(r - MP) * D;
            float* dst = p.out + (size_t)r * D; float s = 0.f;
#pragma unroll
            for (int j = 0; j < 4; ++j) { const int c = 4 * lane + 256 * j; const f32x4 v = *(const f32x4*)(src + c); *(f32x4*)(dst + c) = v;
                u32x2 w; w.x = pk2(v.x, v.y); w.y = pk2(v.z, v.w); *(u32x2*)(XB + (size_t)r * D + c) = w; s += (v.x * v.x + v.y * v.y) + (v.z * v.z + v.w * v.w); }
            s = wave_sum(s); if (lane == 0) SS[r] = (u64)(s * 16777216.f + 0.5f);
        } else {
#pragma unroll
            for (int j = 0; j < 4; ++j) { const int c = 4 * lane + 256 * j; *(u32x2*)(XB + (size_t)r * D + c) = (u32x2){0u, 0u}; }
        }
    }
}

__device__ __forceinline__ void phase_ab(const Params& p, int e, const u64* ss) {
    int tid_ = threadIdx.x; asm volatile("" : "+v"(tid_));
    const int tid = tid_, lane = tid & 63, wave = tid >> 6;
    const int skip = (gridDim.x == 256) ? 16 : 0;
    if ((int)blockIdx.x < skip) return;
    const int gw = ((int)blockIdx.x - skip) * 8 + wave, NGW = ((int)gridDim.x - skip) * 8;
    const bf16_t* XB = (const bf16_t*)(p.ws + WS_XB); const float* WAB = (const float*)(p.ws + WS_WAB) + e * 8 * 1024; float* AB = (float*)(p.ws + WS_AB);
    for (int r = gw; r < MR; r += NGW) {
        float x[16]; const bf16_t* xp = XB + (size_t)r * D + 16 * lane;
        unpack8(*(const u32x4*)xp, x); unpack8(*(const u32x4*)(xp + 8), x + 8);
        const float rs = SS_RS(ss[r]);
#pragma unroll
        for (int j = 0; j < 8; ++j) {
            const float* w = WAB + j * 1024 + 16 * lane; float s = 0.f;
#pragma unroll
            for (int i = 0; i < 4; ++i) { const f32x4 wv = *(const f32x4*)(w + 4 * i); s += x[4 * i] * wv.x + x[4 * i + 1] * wv.y + x[4 * i + 2] * wv.z + x[4 * i + 3] * wv.w; }
            s = wave_sum(s);
            if (lane == 0) AB[(size_t)r * 8 + j] = s * rs;
        }
    }
}

__device__ __forceinline__ void e2_gdn(const Params& p, LAS unsigned char* lds, int e, int item) {
    int tid_ = threadIdx.x; asm volatile("" : "+v"(tid_));
    { unsigned lb_ = (unsigned)(size_t)lds; asm volatile("" : "+v"(lb_)); lds = (LAS unsigned char*)(size_t)lb_; }
    const int tid = tid_, lane = tid & 63, wave = tid >> 6, fr = lane & 15, fq = lane >> 4;
    const int seq = item >> 5, n = item & 31, b = seq >> 2, h = seq & 3;
    const int t = tid >> 3, sub = tid & 7, c0 = sub * 16;
    const int tpos = n * 64 + t; const size_t r = (size_t)b * TP + tpos;
    LAS bf16_t* Qs = (LAS bf16_t*)(lds); LAS bf16_t* Ks = (LAS bf16_t*)(lds + 17408); LAS bf16_t* KBT = (LAS bf16_t*)(lds + 34816); LAS bf16_t* VBT = (LAS bf16_t*)(lds + 53248);
    LAS bf16_t* Tm = (LAS bf16_t*)(lds + 71680); LAS float* Af = (LAS float*)(lds + 80896); LAS float* gv = (LAS float*)(lds + 98304); LAS float* bv = gv + 64; LAS float* btv = gv + 128;
    const bf16_t* P16 = (const bf16_t*)(p.ws + WS_P16); const float* AB = (const float*)(p.ws + WS_AB);
    unsigned char* blk = p.ws + WS_E2G + (size_t)item * E2G_BYTES;
    bf16_t* uT = (bf16_t*)blk; bf16_t* wF = (bf16_t*)(blk + 16384); bf16_t* qF = (bf16_t*)(blk + 32768); bf16_t* kF = (bf16_t*)(blk + 49152); bf16_t* aF = (bf16_t*)(blk + 65536); float* dec = (float*)(blk + 73728);
    if (sub == 0) {
        const float a = AB[r * 8 + h], bb = AB[r * 8 + 4 + h];
        const float Ah = __expf(p.in[10][e * 4 + h]); const float x = a + p.in[11][e * 4 + h];
        const float sp = x > 20.f ? x : log1pf(__expf(x));
        gv[t] = -Ah * sp; btv[t] = sigm(bb);
    }
    float qv[16], kv[16], vv[16];
    const float* cw = p.in[9] + (size_t)e * 4 * 1536;
#pragma unroll
    for (int part = 0; part < 3; ++part) {
        float a[16];
#pragma unroll
        for (int i = 0; i < 16; ++i) a[i] = 0.f;
        const int ch = part * 512 + h * 128 + c0;
        if (n > 0) {
#pragma unroll
        for (int j = 0; j < 4; ++j) {
            {
                const bf16_t* src = P16 + (r - 3 + j) * 4096 + 2048 + ch; float x[16];
                unpack8(*(const u32x4*)src, x); unpack8(*(const u32x4*)(src + 8), x + 8);
                const float* w = cw + j * 1536 + ch;
#pragma unroll
                for (int i = 0; i < 4; ++i) { const f32x4 wv = *(const f32x4*)(w + 4 * i); a[4 * i] += x[4 * i] * wv.x; a[4 * i + 1] += x[4 * i + 1] * wv.y; a[4 * i + 2] += x[4 * i + 2] * wv.z; a[4 * i + 3] += x[4 * i + 3] * wv.w; }
                if (j == 3 && n == 31 && t >= 61) {
                    float* o = p.out + O_CVP + ((size_t)(e * NB + b) * 3 + (t - 61)) * 1536 + ch;
#pragma unroll
                    for (int i = 0; i < 4; ++i) *(f32x4*)(o + 4 * i) = (f32x4){x[4 * i], x[4 * i + 1], x[4 * i + 2], x[4 * i + 3]};
                }
            }
        }
        } else {
#pragma unroll
        for (int j = 0; j < 4; ++j) {
            if (tpos - 3 + j >= 0) {
                const bf16_t* src = P16 + (r - 3 + j) * 4096 + 2048 + ch; float x[16];
                unpack8(*(const u32x4*)src, x); unpack8(*(const u32x4*)(src + 8), x + 8);
                const float* w = cw + j * 1536 + ch;
#pragma unroll
                for (int i = 0; i < 4; ++i) { const f32x4 wv = *(const f32x4*)(w + 4 * i); a[4 * i] += x[4 * i] * wv.x; a[4 * i + 1] += x[4 * i + 1] * wv.y; a[4 * i + 2] += x[4 * i + 2] * wv.z; a[4 * i + 3] += x[4 * i + 3] * wv.w; }
                if (j == 3 && n == 31 && t >= 61) {
                    float* o = p.out + O_CVP + ((size_t)(e * NB + b) * 3 + (t - 61)) * 1536 + ch;
#pragma unroll
                    for (int i = 0; i < 4; ++i) *(f32x4*)(o + 4 * i) = (f32x4){x[4 * i], x[4 * i + 1], x[4 * i + 2], x[4 * i + 3]};
                }
            }
        }
        }
#pragma unroll
        for (int i = 0; i < 16; ++i) { const float s = silu(a[i]); if (part == 0) qv[i] = s; else if (part == 1) kv[i] = s; else vv[i] = s; }
    }
    float qs = 0.f, ks = 0.f;
#pragma unroll
    for (int i = 0; i < 16; ++i) { qs += qv[i] * qv[i]; ks += kv[i] * kv[i]; }
    qs += __shfl_xor(qs, 1); qs += __shfl_xor(qs, 2); qs += __shfl_xor(qs, 4);
    ks += __shfl_xor(ks, 1); ks += __shfl_xor(ks, 2); ks += __shfl_xor(ks, 4);
    const float qn = rsqrtf(qs + EPS) * 0.08838834764831845f, kn = rsqrtf(ks + EPS);
    __syncthreads();
    if (wave == 0) {
        float x = gv[lane];
#pragma unroll
        for (int o = 1; o < 64; o <<= 1) { const float y = __shfl_up(x, o); if (lane >= o) x += y; }
        bv[lane] = x;
    }
    __syncthreads();
    const float bt = bv[t], bl = bv[63];
    const float beta = btv[t], ebt = __expf(bt), ekl = __expf(bl - bt);
    if (tid == 0) dec[0] = __expf(bl);
    {
        float tq[16], tk[16], tqq[16];
#pragma unroll
        for (int i = 0; i < 16; ++i) { tq[i] = qv[i] * qn; tk[i] = kv[i] * kn; tqq[i] = tq[i] * ebt; }
        *(LAS u32x4*)(Qs + t * 136 + c0) = pack8(tq); *(LAS u32x4*)(Qs + t * 136 + c0 + 8) = pack8(tq + 8);
        *(LAS u32x4*)(Ks + t * 136 + c0) = pack8(tk); *(LAS u32x4*)(Ks + t * 136 + c0 + 8) = pack8(tk + 8);
        *(u32x4*)(qF + fo_off(t, c0, 4)) = pack8(tqq); *(u32x4*)(qF + fo_off(t, c0 + 8, 4)) = pack8(tqq + 8);
#pragma unroll
        for (int i = 0; i < 16; ++i) {
            KBT[(c0 + i) * 72 + t] = f2bf(tk[i] * beta * ebt);
            VBT[(c0 + i) * 72 + t] = f2bf(vv[i] * beta);
            kF[fo_off(c0 + i, t, 2)] = f2bf(tk[i] * ekl);
        }
    }
    __syncthreads();
#pragma unroll
    for (int q2 = 0; q2 < 2; ++q2) {
        const int id = 2 * wave + q2, mt = id >> 2, nt = id & 3;
        f32x4 a1 = {0.f, 0.f, 0.f, 0.f}, a2 = {0.f, 0.f, 0.f, 0.f};
#pragma unroll
        for (int ks4 = 0; ks4 < 4; ++ks4) {
            const bf16x8 km = *(const LAS bf16x8*)(Ks + (16 * mt + fr) * 136 + 32 * ks4 + 8 * fq);
            const bf16x8 kn2 = *(const LAS bf16x8*)(Ks + (16 * nt + fr) * 136 + 32 * ks4 + 8 * fq);
            const bf16x8 qn2 = *(const LAS bf16x8*)(Qs + (16 * nt + fr) * 136 + 32 * ks4 + 8 * fq);
            a1 = mfma16(km, kn2, a1);
            a2 = mfma16(km, qn2, a2);
        }
        {
            const int s = 16 * nt + fr; const float bs = bv[s];
#pragma unroll
            for (int j = 0; j < 4; ++j) { const int tt = 16 * mt + 4 * fq + j; Af[tt * 68 + s] = (s < tt) ? btv[tt] * a1[j] * __expf(bv[tt] - bs) : 0.f; }
        }
        {
            const int tt = 16 * nt + fr; const float btt = bv[tt]; float o[4];
#pragma unroll
            for (int j = 0; j < 4; ++j) { const int s = 16 * mt + 4 * fq + j; o[j] = (s <= tt) ? a2[j] * __expf(btt - bv[s]) : 0.f; }
            u32x2 w; w.x = pk2(o[0], o[1]); w.y = pk2(o[2], o[3]);
            *(u32x2*)(aF + fo_off(tt, 16 * mt + 4 * fq, 2)) = w;
        }
    }
    __syncthreads();
    if (wave == 0) {
        float Tc[64];
#pragma unroll
        for (int i = 0; i < 64; ++i) Tc[i] = 0.f;
#pragma unroll
        for (int tt = 1; tt < 64; ++tt) {
            float s0 = -Af[tt * 68 + lane], s1 = 0.f, s2 = 0.f, s3 = 0.f;
#pragma unroll
            for (int s4 = 0; s4 < (tt + 3) / 4; ++s4) {
                const f32x4 av = *(const LAS f32x4*)(Af + tt * 68 + 4 * s4);
                s0 -= av.x * Tc[4 * s4]; s1 -= av.y * Tc[4 * s4 + 1]; s2 -= av.z * Tc[4 * s4 + 2]; s3 -= av.w * Tc[4 * s4 + 3];
            }
            Tc[tt] = (s0 + s1) + (s2 + s3);
        }
#pragma unroll
        for (int tt = 0; tt < 64; ++tt) Tm[tt * 72 + lane] = f2bf(Tc[tt]);
        LDS_WAIT();
        Tm[lane * 72 + lane] = (bf16_t)0x3F80;
    }
    __syncthreads();
#pragma unroll
    for (int mt = 0; mt < 4; ++mt) {
        f32x4 a = {0.f, 0.f, 0.f, 0.f};
#pragma unroll
        for (int k2 = 0; k2 < 2; ++k2) a = mfma16(*(const LAS bf16x8*)(Tm + (16 * mt + fr) * 72 + 32 * k2 + 8 * fq), *(const LAS bf16x8*)(VBT + (16 * wave + fr) * 72 + 32 * k2 + 8 * fq), a);
        u32x2 w; w.x = pk2(a[0], a[1]); w.y = pk2(a[2], a[3]);
        *(u32x2*)(uT + ((wave * 4 + mt) * 64 + lane) * 4) = w;
    }
#pragma unroll
    for (int nt = 0; nt < 4; ++nt) {
        f32x4 a = {0.f, 0.f, 0.f, 0.f};
#pragma unroll
        for (int k2 = 0; k2 < 2; ++k2) a = mfma16(*(const LAS bf16x8*)(KBT + (16 * wave + fr) * 72 + 32 * k2 + 8 * fq), *(const LAS bf16x8*)(Tm + (16 * nt + fr) * 72 + 32 * k2 + 8 * fq), a);
        u32x2 w; w.x = pk2(a[0], a[1]); w.y = pk2(a[2], a[3]);
        *(u32x2*)(wF + fo_off(16 * nt + fr, 16 * wave + 4 * fq, 4)) = w;
    }
    __syncthreads();
}

__device__ __forceinline__ void e2_hgrn(const Params& p, LAS unsigned char* lds, int item) {
    int tid_ = threadIdx.x; asm volatile("" : "+v"(tid_));
    { unsigned lb_ = (unsigned)(size_t)lds; asm volatile("" : "+v"(lb_)); lds = (LAS unsigned char*)(size_t)lb_; }
    const int tid = tid_, lane = tid & 63, wave = tid >> 6, fr = lane & 15, fq = lane >> 4;
    const int seq = item >> 5, n = item & 31, b = seq >> 2, h = seq & 3;
    const int t = tid >> 3, sub = tid & 7, c0 = sub * 16;
    const size_t r = (size_t)b * TP + n * 64 + t;
    LAS float* Bf = (LAS float*)lds; LAS bf16_t* Qm = (LAS bf16_t*)(lds + 33792); LAS bf16_t* Km = (LAS bf16_t*)(lds + 51200);
    const bf16_t* P16 = (const bf16_t*)(p.ws + WS_P16); const float* LOGG = (const float*)(p.ws + WS_LOGG);
    unsigned char* blk = p.ws + WS_E2H + (size_t)item * E2H_BYTES;
    bf16_t* qF = (bf16_t*)blk; bf16_t* kF = (bf16_t*)(blk + 16384); bf16_t* vF = (bf16_t*)(blk + 32768); bf16_t* aF = (bf16_t*)(blk + 49152); float* ebl = (float*)(blk + 57344);
    {
        const float* lp = LOGG + r * 512 + h * 128 + c0;
#pragma unroll
        for (int i = 0; i < 4; ++i) *(LAS f32x4*)(Bf + t * 132 + c0 + 4 * i) = *(const f32x4*)(lp + 4 * i);
    }
    __syncthreads();
    if (tid < 128) { float run = 0.f; for (int i = 0; i < 64; ++i) { run += Bf[i * 132 + tid]; Bf[i * 132 + tid] = run; } }
    __syncthreads();
    {
        float q[16], k[16]; const bf16_t* pr = P16 + r * 4096 + h * 128 + c0;
        unpack8(*(const u32x4*)pr, q); unpack8(*(const u32x4*)(pr + 8), q + 8);
        unpack8(*(const u32x4*)(pr + 512), k); unpack8(*(const u32x4*)(pr + 520), k + 8);
        const u32x4 v0 = *(const u32x4*)(pr + 1024), v1 = *(const u32x4*)(pr + 1032);
        const unsigned vw[8] = {v0.x, v0.y, v0.z, v0.w, v1.x, v1.y, v1.z, v1.w};
        float tq[16], tqm[16], tkm[16];
#pragma unroll
        for (int i = 0; i < 16; ++i) {
            const float bt = Bf[t * 132 + c0 + i], bl = Bf[63 * 132 + c0 + i], bm = Bf[31 * 132 + c0 + i];
            tq[i] = q[i] * __expf(bt); tqm[i] = q[i] * __expf(bt - bm); tkm[i] = k[i] * __expf(bm - bt);
            kF[fo_off(c0 + i, t, 2)] = f2bf(k[i] * __expf(bl - bt));
            vF[fo_off(c0 + i, t, 2)] = (bf16_t)((i & 1) ? (vw[i >> 1] >> 16) : (vw[i >> 1] & 0xffffu));
            if (t == 0) ebl[c0 + i] = __expf(bl);
        }
        *(u32x4*)(qF + fo_off(t, c0, 4)) = pack8(tq); *(u32x4*)(qF + fo_off(t, c0 + 8, 4)) = pack8(tq + 8);
        *(LAS u32x4*)(Qm + t * 136 + c0) = pack8(tqm); *(LAS u32x4*)(Qm + t * 136 + c0 + 8) = pack8(tqm + 8);
        *(LAS u32x4*)(Km + t * 136 + c0) = pack8(tkm); *(LAS u32x4*)(Km + t * 136 + c0 + 8) = pack8(tkm + 8);
    }
    __syncthreads();
#pragma unroll
    for (int q2 = 0; q2 < 2; ++q2) {
        const int id = 2 * wave + q2, mt = id >> 2, nt = id & 3;
        f32x4 a = {0.f, 0.f, 0.f, 0.f};
#pragma unroll
        for (int ks4 = 0; ks4 < 4; ++ks4) a = mfma16(*(const LAS bf16x8*)(Km + (16 * mt + fr) * 136 + 32 * ks4 + 8 * fq), *(const LAS bf16x8*)(Qm + (16 * nt + fr) * 136 + 32 * ks4 + 8 * fq), a);
        const int tt = 16 * nt + fr; float o[4];
#pragma unroll
        for (int j = 0; j < 4; ++j) { const int s = 16 * mt + 4 * fq + j; o[j] = (s <= tt) ? a[j] : 0.f; }
        u32x2 w; w.x = pk2(o[0], o[1]); w.y = pk2(o[2], o[3]);
        *(u32x2*)(aF + fo_off(tt, 16 * mt + 4 * fq, 2)) = w;
    }
    __syncthreads();
}

template <bool GDN>
__device__ __forceinline__ void e3_prompt(const Params& p, LAS unsigned char* lds, int e, int seq) {
    int tid_ = threadIdx.x; asm volatile("" : "+v"(tid_));
    { unsigned lb_ = (unsigned)(size_t)lds; asm volatile("" : "+v"(lb_)); lds = (LAS unsigned char*)(size_t)lb_; }
    const int tid = tid_, lane = tid & 63, wave = tid >> 6, fr = lane & 15, fq = lane >> 4;
    const int b = seq >> 2, h = seq & 3, v0 = wave * 16;
    LAS bf16_t* SLw = (LAS bf16_t*)(lds) + wave * (16 * 136); LAS bf16_t* VTw = (LAS bf16_t*)(lds + 34816) + wave * (16 * 72);
    LAS float* OT = (LAS float*)(lds + 53248);
    LAS float* EBw = (LAS float*)(lds + 120832) + wave * 128;
    const bf16_t* P16 = (const bf16_t*)(p.ws + WS_P16); bf16_t* OA = (bf16_t*)(p.ws + WS_OA);
    const float* nw = (GDN ? p.in[12] : p.in[8]) + e * 128;
    constexpr size_t IB = GDN ? E2G_BYTES : E2H_BYTES;
    constexpr int QF = GDN ? 32768 : 0, AF = GDN ? 65536 : 49152, KF = GDN ? 49152 : 16384;
    const unsigned char* base = p.ws + (GDN ? WS_E2G : WS_E2H) + (size_t)seq * 32 * IB;
    const int t = tid >> 3, sub = tid & 7, c0 = sub * 16;
    f32x4 S[8];
#pragma unroll
    for (int kt = 0; kt < 8; ++kt) S[kt] = (f32x4){0.f, 0.f, 0.f, 0.f};
    for (int n = 0; n < 32; ++n) {
        const unsigned char* blk = base + (size_t)n * IB;
        unsigned pf0 = 0u, pf1 = 0u;
        if (n + 1 < 32) { pf0 = *(const unsigned*)(blk + IB + (size_t)tid * 128); if ((size_t)65536 + (size_t)tid * 128 < IB) pf1 = *(const unsigned*)(blk + IB + 65536 + (size_t)tid * 128); }
        bf16x8 bS[4], bV[2], qA[16], aA[8], kA[16];
        LAS float* OTc = OT + (n & 1) * (64 * 132);
        const size_t r = (size_t)b * TP + n * 64 + t;
        const bf16_t* gp = P16 + r * 4096 + (GDN ? 3584 : 1536) + h * 128 + c0;
        u32x4 g0, g1;
        if (GDN) {
            bf16x8 wA[16]; u32x2 uu[4];
#pragma unroll
            for (int i = 0; i < 16; ++i) wA[i] = *(const bf16x8*)((const bf16_t*)(blk + 16384) + (i * 64 + lane) * 8);
#pragma unroll
            for (int mt = 0; mt < 4; ++mt) uu[mt] = *(const u32x2*)((const bf16_t*)blk + ((wave * 4 + mt) * 64 + lane) * 4);
#pragma unroll
            for (int i = 0; i < 16; ++i) qA[i] = *(const bf16x8*)((const bf16_t*)(blk + QF) + (i * 64 + lane) * 8);
#pragma unroll
            for (int kt = 0; kt < 8; ++kt) { u32x2 w2; w2.x = pk2(S[kt].x, S[kt].y); w2.y = pk2(S[kt].z, S[kt].w); *(LAS u32x2*)(SLw + fr * 136 + 16 * kt + 4 * fq) = w2; }
#pragma unroll
            for (int ks = 0; ks < 4; ++ks) bS[ks] = *(const LAS bf16x8*)(SLw + fr * 136 + 32 * ks + 8 * fq);
            __builtin_amdgcn_sched_barrier(0);
#pragma unroll
            for (int mt = 0; mt < 4; ++mt) {
                f32x4 pa = {0.f, 0.f, 0.f, 0.f};
#pragma unroll
                for (int ks = 0; ks < 4; ++ks) pa = mfma16(wA[mt * 4 + ks], bS[ks], pa);
                u32x2 w2; w2.x = pk2(bflo(uu[mt].x) - pa.x, bfhi(uu[mt].x) - pa.y); w2.y = pk2(bflo(uu[mt].y) - pa.z, bfhi(uu[mt].y) - pa.w);
                *(LAS u32x2*)(VTw + fr * 72 + 16 * mt + 4 * fq) = w2;
            }
#pragma unroll
            for (int i = 0; i < 8; ++i) aA[i] = *(const bf16x8*)((const bf16_t*)(blk + AF) + (i * 64 + lane) * 8);
            const float d = *(const float*)(blk + 73728);
#pragma unroll
            for (int k2 = 0; k2 < 2; ++k2) bV[k2] = *(const LAS bf16x8*)(VTw + fr * 72 + 32 * k2 + 8 * fq);
            __builtin_amdgcn_sched_barrier(0);
            f32x4 acc[4];
#pragma unroll
            for (int mt = 0; mt < 4; ++mt) {
                acc[mt] = (f32x4){0.f, 0.f, 0.f, 0.f};
#pragma unroll
                for (int ks = 0; ks < 4; ++ks) acc[mt] = mfma16(qA[mt * 4 + ks], bS[ks], acc[mt]);
            }
#pragma unroll
            for (int i = 0; i < 16; ++i) kA[i] = *(const bf16x8*)((const bf16_t*)(blk + KF) + (i * 64 + lane) * 8);
            g0 = *(const u32x4*)gp; g1 = *(const u32x4*)(gp + 8);
            __builtin_amdgcn_sched_barrier(0);
#pragma unroll
            for (int mt = 0; mt < 4; ++mt) {
#pragma unroll
                for (int k2 = 0; k2 < 2; ++k2) acc[mt] = mfma16(aA[mt * 2 + k2], bV[k2], acc[mt]);
#pragma unroll
                for (int j = 0; j < 4; ++j) OTc[(16 * mt + 4 * fq + j) * 132 + v0 + fr] = acc[mt][j];
            }
#pragma unroll
            for (int kt = 0; kt < 8; ++kt) {
                S[kt] = S[kt] * d;
#pragma unroll
                for (int k2 = 0; k2 < 2; ++k2) S[kt] = mfma16(kA[kt * 2 + k2], bV[k2], S[kt]);
            }
        } else {
#pragma unroll
            for (int i = 0; i < 16; ++i) qA[i] = *(const bf16x8*)((const bf16_t*)(blk + QF) + (i * 64 + lane) * 8);
#pragma unroll
            for (int i = 0; i < 8; ++i) aA[i] = *(const bf16x8*)((const bf16_t*)(blk + AF) + (i * 64 + lane) * 8);
#pragma unroll
            for (int k2 = 0; k2 < 2; ++k2) bV[k2] = *(const bf16x8*)((const bf16_t*)(blk + 32768) + ((wave * 2 + k2) * 64 + lane) * 8);
            const f32x4 ev = *(const f32x4*)((const float*)(blk + 57344) + 4 * (lane & 31));
#pragma unroll
            for (int kt = 0; kt < 8; ++kt) { u32x2 w2; w2.x = pk2(S[kt].x, S[kt].y); w2.y = pk2(S[kt].z, S[kt].w); *(LAS u32x2*)(SLw + fr * 136 + 16 * kt + 4 * fq) = w2; }
#pragma unroll
            for (int ks = 0; ks < 4; ++ks) bS[ks] = *(const LAS bf16x8*)(SLw + fr * 136 + 32 * ks + 8 * fq);
            __builtin_amdgcn_sched_barrier(0);
            f32x4 acc[4];
#pragma unroll
            for (int mt = 0; mt < 4; ++mt) {
                acc[mt] = (f32x4){0.f, 0.f, 0.f, 0.f};
#pragma unroll
                for (int ks = 0; ks < 4; ++ks) acc[mt] = mfma16(qA[mt * 4 + ks], bS[ks], acc[mt]);
            }
#pragma unroll
            for (int i = 0; i < 16; ++i) kA[i] = *(const bf16x8*)((const bf16_t*)(blk + KF) + (i * 64 + lane) * 8);
            g0 = *(const u32x4*)gp; g1 = *(const u32x4*)(gp + 8);
            if (lane < 32) *(LAS f32x4*)(EBw + 4 * lane) = ev;
            __builtin_amdgcn_sched_barrier(0);
#pragma unroll
            for (int mt = 0; mt < 4; ++mt) {
#pragma unroll
                for (int k2 = 0; k2 < 2; ++k2) acc[mt] = mfma16(aA[mt * 2 + k2], bV[k2], acc[mt]);
#pragma unroll
                for (int j = 0; j < 4; ++j) OTc[(16 * mt + 4 * fq + j) * 132 + v0 + fr] = acc[mt][j];
            }
#pragma unroll
            for (int kt = 0; kt < 8; ++kt) {
                S[kt] = S[kt] * *(const LAS f32x4*)(EBw + 16 * kt + 4 * fq);
#pragma unroll
                for (int k2 = 0; k2 < 2; ++k2) S[kt] = mfma16(kA[kt * 2 + k2], bV[k2], S[kt]);
            }
        }
        asm volatile("" :: "v"(pf0), "v"(pf1));
        __syncthreads();
        {
            float o[16]; float sq = 0.f;
#pragma unroll
            for (int i = 0; i < 4; ++i) { const f32x4 v = *(const LAS f32x4*)(OTc + t * 132 + c0 + 4 * i); o[4 * i] = v.x; o[4 * i + 1] = v.y; o[4 * i + 2] = v.z; o[4 * i + 3] = v.w; sq += (v.x * v.x + v.y * v.y) + (v.z * v.z + v.w * v.w); }
            sq += __shfl_xor(sq, 1); sq += __shfl_xor(sq, 2); sq += __shfl_xor(sq, 4);
            const float rstd = rsqrtf(sq * (1.f / 128.f) + EPS);
            float gt[16]; unpack8(g0, gt); unpack8(g1, gt + 8);
#pragma unroll
            for (int i = 0; i < 16; ++i) { const float gate = GDN ? silu(gt[i]) : sigm(gt[i]); o[i] = o[i] * rstd * nw[c0 + i] * gate; }
            bf16_t* op = OA + r * D + (GDN ? 512 : 0) + h * 128 + c0;
            *(u32x4*)op = pack8(o); *(u32x4*)(op + 8) = pack8(o + 8);
        }
    }
    float* so = p.out + (GDN ? O_GDP : O_HGP) + ((size_t)(e * NB + b) * 4 + h) * 16384;
#pragma unroll
    for (int kt = 0; kt < 8; ++kt)
#pragma unroll
        for (int j = 0; j < 4; ++j) so[(16 * kt + 4 * fq + j) * 128 + v0 + fr] = S[kt][j];
    __syncthreads();
}

__device__ __forceinline__ void e3_sample(const Params& p, LAS unsigned char* lds, int e, int mx, int bh) {
    int tid_ = threadIdx.x; asm volatile("" : "+v"(tid_));
    { unsigned lb_ = (unsigned)(size_t)lds; asm volatile("" : "+v"(lb_)); lds = (LAS unsigned char*)(size_t)lb_; }
    const int tid = tid_, lane = tid & 63, wave = tid >> 6;
    const int b = bh >> 2, h = bh & 3; const size_t r = (size_t)MP + b;
    const bool gdn = (mx == 1);
    LAS float* qs = (LAS float*)lds; LAS float* ks = qs + 128; LAS float* gs = qs + 256; LAS float* vs = qs + 384; LAS float* vn = qs + 512; LAS float* misc = qs + 640; LAS float* red = qs + 1024;
    const bf16_t* P16 = (const bf16_t*)(p.ws + WS_P16); bf16_t* OA = (bf16_t*)(p.ws + WS_OA);
    float eg = 1.f, beta = 0.f;
    if (tid < 128) {
        const int c = tid;
        if (!gdn) {
            const bf16_t* pr = P16 + r * 4096 + h * 128 + c;
            qs[c] = bf2f(pr[0]); ks[c] = bf2f(pr[512]); vs[c] = bf2f(pr[1024]);
            gs[c] = __expf(((const float*)(p.ws + WS_LOGG))[r * 512 + h * 128 + c]);
        } else {
            const float* cw = p.in[9] + (size_t)e * 4 * 1536; const float* cb = p.in[4] + (size_t)(e * MS + b) * 3 * 1536;
            float* cso = p.out + O_CVS + (size_t)(e * MS + b) * 3 * 1536; float val[3];
#pragma unroll
            for (int part = 0; part < 3; ++part) {
                const int ch = part * 512 + h * 128 + c; const float x3 = bf2f(P16[r * 4096 + 2048 + ch]);
                const float b0 = cb[ch], b1 = cb[1536 + ch], b2 = cb[3072 + ch];
                val[part] = silu(b0 * cw[ch] + b1 * cw[1536 + ch] + b2 * cw[3072 + ch] + x3 * cw[4608 + ch]);
                cso[ch] = b1; cso[1536 + ch] = b2; cso[3072 + ch] = x3;
            }
            float q2 = wave_sum(val[0] * val[0]), k2 = wave_sum(val[1] * val[1]);
            if (lane == 0) { misc[wave] = q2; misc[2 + wave] = k2; }
            qs[c] = val[0]; ks[c] = val[1]; vs[c] = val[2];
        }
    }
    __syncthreads();
    if (gdn) {
        const float qn = rsqrtf(misc[0] + misc[1] + EPS) * 0.08838834764831845f, kn = rsqrtf(misc[2] + misc[3] + EPS);
        const float* AB = (const float*)(p.ws + WS_AB);
        const float a = AB[r * 8 + h], bb = AB[r * 8 + 4 + h];
        const float Ah = __expf(p.in[10][e * 4 + h]); const float x = a + p.in[11][e * 4 + h];
        const float sp = x > 20.f ? x : log1pf(__expf(x));
        eg = __expf(-Ah * sp); beta = sigm(bb);
        __syncthreads();
        if (tid < 128) { qs[tid] *= qn; ks[tid] *= kn; }
        __syncthreads();
    }
    const int c4 = (tid & 31) * 4, rg = tid >> 5;
    const float* s0 = (gdn ? p.in[3] : p.in[2]) + ((size_t)(e * MS + b) * 4 + h) * 16384;
    float* so = p.out + (gdn ? O_GDS : O_HGS) + ((size_t)(e * MS + b) * 4 + h) * 16384;
    f32x4 Sv[8];
#pragma unroll
    for (int i = 0; i < 8; ++i) Sv[i] = *(const f32x4*)(s0 + (rg + 16 * i) * 128 + c4);
    f32x4 vv;
    if (gdn) {
        f32x4 pk = {0.f, 0.f, 0.f, 0.f};
#pragma unroll
        for (int i = 0; i < 8; ++i) pk = pk + Sv[i] * ks[rg + 16 * i];
        *(LAS f32x4*)(red + rg * 128 + c4) = pk;
        __syncthreads();
        if (tid < 128) { float s = 0.f;
#pragma unroll
            for (int i = 0; i < 16; ++i) s += red[i * 128 + tid];
            vn[tid] = beta * vs[tid] - beta * eg * s; }
        __syncthreads();
        vv = *(const LAS f32x4*)(vn + c4);
    } else vv = *(const LAS f32x4*)(vs + c4);
    f32x4 po = {0.f, 0.f, 0.f, 0.f};
#pragma unroll
    for (int i = 0; i < 8; ++i) {
        const int k = rg + 16 * i; const float dk = gdn ? eg : gs[k];
        const f32x4 sn = Sv[i] * dk + vv * ks[k];
        *(f32x4*)(so + k * 128 + c4) = sn;
        po = po + sn * qs[k];
    }
    __syncthreads();
    *(LAS f32x4*)(red + rg * 128 + c4) = po;
    __syncthreads();
    float o = 0.f;
    if (tid < 128) {
#pragma unroll
        for (int i = 0; i < 16; ++i) o += red[i * 128 + tid];
        const float s2 = wave_sum(o * o); if (lane == 0) misc[4 + wave] = s2;
    }
    __syncthreads();
    if (tid < 128) {
        const float rstd = rsqrtf((misc[4] + misc[5]) * (1.f / 128.f) + EPS);
        const float gr = bf2f(P16[r * 4096 + (gdn ? 3584 : 1536) + h * 128 + tid]);
        const float gate = gdn ? silu(gr) : sigm(gr);
        const float nwv = (gdn ? p.in[12] : p.in[8])[e * 128 + tid];
        OA[r * D + (gdn ? 512 : 0) + h * 128 + tid] = f2bf(o * rstd * nwv * gate);
    }
    __syncthreads();
}

__device__ __forceinline__ void phase_pool(const Params& p, int o) {
    const bf16_t* U = (const bf16_t*)(p.ws + WS_P16); bf16_t* Dp = (bf16_t*)(p.ws + WS_P16 + (size_t)M * 1024 * 2);
    int tid_ = threadIdx.x; asm volatile("" : "+v"(tid_));
    const int gt = blockIdx.x * 512 + tid_, NGT = gridDim.x * 512;
    for (int idx = gt; idx < MR * 128; idx += NGT) {
        const int r = idx >> 7, c = (idx & 127) * 8, w = 2 << (c >> 8);
        float u[8], s[8]; unpack8(*(const u32x4*)(U + (size_t)r * D + c), u);
#pragma unroll
        for (int i = 0; i < 8; ++i) s[i] = u[i];
        float cnt;
        if (r < MP) {
            const int t = r & (TP - 1), b = r >> 11; cnt = (float)((t + 1 < w) ? t + 1 : w);
            const int lim = (w - 1 < t) ? w - 1 : t;
            u32x4 xr[15];
#pragma unroll
            for (int i = 1; i < 16; ++i) xr[i - 1] = *(const u32x4*)(U + (size_t)(r - ((i <= lim) ? i : 0)) * D + c);
#pragma unroll
            for (int i = 1; i < 16; ++i) { float x[8]; unpack8(xr[i - 1], x); const float m = (i <= lim) ? 1.f : 0.f;
#pragma unroll
                for (int q = 0; q < 8; ++q) s[q] += m * x[q]; }
            if (t >= TP - 15) { float* op = p.out + O_PLP + ((size_t)(o * NB + b) * 15 + (t - (TP - 15))) * D + c;
                *(f32x4*)op = (f32x4){u[0], u[1], u[2], u[3]}; *(f32x4*)(op + 4) = (f32x4){u[4], u[5], u[6], u[7]}; }
        } else {
            const int b = r - MP; cnt = (float)w;
            const float* buf = p.in[5] + (size_t)(o * MS + b) * 15 * D + c;
#pragma unroll
            for (int i = 1; i < 16; ++i) { if (i < w) { const f32x4 x0 = *(const f32x4*)(buf + (15 - i) * D), x1 = *(const f32x4*)(buf + (15 - i) * D + 4);
                s[0] += x0.x; s[1] += x0.y; s[2] += x0.z; s[3] += x0.w; s[4] += x1.x; s[5] += x1.y; s[6] += x1.z; s[7] += x1.w; } }
            float* op = p.out + O_PLS + (size_t)(o * MS + b) * 15 * D + c;
#pragma unroll
            for (int j = 0; j < 14; ++j) { *(f32x4*)(op + j * D) = *(const f32x4*)(buf + (j + 1) * D); *(f32x4*)(op + j * D + 4) = *(const f32x4*)(buf + (j + 1) * D + 4); }
            *(f32x4*)(op + 14 * D) = (f32x4){u[0], u[1], u[2], u[3]}; *(f32x4*)(op + 14 * D + 4) = (f32x4){u[4], u[5], u[6], u[7]};
        }
        const float ic = 1.f / cnt; float d[8];
#pragma unroll
        for (int i = 0; i < 8; ++i) d[i] = s[i] * ic - u[i];
        *(u32x4*)(Dp + (size_t)r * D + c) = pack8(d);
    }
}

__device__ __forceinline__ void phase_final(const Params& p) {
    int tid_ = threadIdx.x; asm volatile("" : "+v"(tid_));
    const int tid = tid_, lane = tid & 63, wave = tid >> 6;
    const int gw = blockIdx.x * 8 + wave, NGW = gridDim.x * 8;
    const u64* ss = (const u64*)(p.ws + WS_SS) + (size_t)12 * M; const float* fw = p.in[26];
    for (int r = gw; r < MR; r += NGW) {
        const float rs = SS_RS(ss[r]); float* xp = p.out + (size_t)r * D;
#pragma unroll
        for (int j = 0; j < 4; ++j) { const int c = 4 * lane + 256 * j; const f32x4 v = *(const f32x4*)(xp + c); const f32x4 w = *(const f32x4*)(fw + c); f32x4 y = v * w * rs;
            *(f32x4*)(xp + c) = y; }
    }
}

#define XB_TMO      128
#define XB_XCNT(j)  (256  + 64 * (j))
#define XB_XSUB(j)  (1280 + 64 * (j))
#define XB_XGEN(j)  (2304 + 64 * (j))
#define XB_TOP      3328
#define XB_TOPGEN   3392
#define XCD_BAR_WORDS 3456
#define TS_OFF (WS_END + 16384)
#define XB_SPIN_CAP (1u << 22)
__device__ __forceinline__ unsigned xb_ld(unsigned* p) { return __hip_atomic_load(p, __ATOMIC_RELAXED, __HIP_MEMORY_SCOPE_AGENT); }
__device__ __forceinline__ unsigned xb_add(unsigned* p, unsigned v) { return __hip_atomic_fetch_add(p, v, __ATOMIC_RELAXED, __HIP_MEMORY_SCOPE_AGENT); }
__device__ __forceinline__ unsigned xb_xcc_id() { return (unsigned)__builtin_amdgcn_s_getreg((3 << 11) | 20) & 0xFu; }
#define XB_SPIN(cond, bar) do { unsigned _sp = 0; while (cond) { __builtin_amdgcn_s_sleep(1); \
    if ((++_sp & 255u) == 0u) { if (xb_ld(&(bar)[XB_TMO])) break; if (_sp > XB_SPIN_CAP) { atomicAdd(&(bar)[XB_TMO], 1u); break; } } } } while (0)
struct XcdBarrier { unsigned* bar; unsigned x; volatile LAS unsigned* st; };
__device__ __forceinline__ XcdBarrier xcd_barrier_post(unsigned* bar, volatile LAS unsigned* st) {
    XcdBarrier b; b.bar = bar; b.x = xb_xcc_id(); b.st = st;
    if (threadIdx.x == 0) (void)xb_add(&bar[XB_XCNT(b.x)], 1u);
    return b;
}
__device__ __forceinline__ void xcd_barrier_complete(unsigned* bar, unsigned x, unsigned& nloc, unsigned& nx) {
    const unsigned G = gridDim.x * gridDim.y * gridDim.z;
    unsigned sum, cnt, mine, sp = 0u;
    for (;;) {
        sum = 0u; cnt = 0u; mine = 0u;
#pragma unroll
        for (unsigned j = 0; j < 16; ++j) { const unsigned c = xb_ld(&bar[XB_XCNT(j)]); sum += c; cnt += (c > 0u) ? 1u : 0u; mine = (j == x) ? c : mine; }
        if (sum == G) break;
        __builtin_amdgcn_s_sleep(1);
        if ((++sp & 255u) == 0u) { if (xb_ld(&bar[XB_TMO])) break; if (sp > XB_SPIN_CAP) { atomicAdd(&bar[XB_TMO], 1u); break; } }
    }
    nloc = mine > 0u ? mine : 1u; nx = cnt > 0u ? cnt : 1u;
}
__device__ __forceinline__ void xcd_barrier(const XcdBarrier& b) {
    asm volatile("s_waitcnt vmcnt(0)" ::: "memory");
    __syncthreads();
    if (threadIdx.x == 0) {
        unsigned* bar = b.bar;
        __builtin_amdgcn_s_waitcnt(0);
        unsigned nloc = b.st[0], nx = b.st[1];
        if (nloc == 0u) { xcd_barrier_complete(bar, b.x, nloc, nx); b.st[0] = nloc; b.st[1] = nx; }
        const unsigned old = xb_add(&bar[XB_XSUB(b.x)], 1u);
        const unsigned gen = old / nloc;
        if (old + 1u == (gen + 1u) * nloc) {
            __builtin_amdgcn_fence(__ATOMIC_RELEASE, "agent");
            asm volatile("s_waitcnt vmcnt(0)" ::: "memory");
            const unsigned og = xb_add(&bar[XB_TOP], 1u);
            const unsigned tg = og / nx;
            if (og + 1u == (tg + 1u) * nx) xb_add(&bar[XB_TOPGEN], 1u);
            else XB_SPIN(xb_ld(&bar[XB_TOPGEN]) == tg, bar);
            __builtin_amdgcn_fence(__ATOMIC_ACQUIRE, "agent");
            xb_add(&bar[XB_XGEN(b.x)], 1u);
            asm volatile("s_waitcnt vmcnt(0)" ::: "memory");
        } else {
            XB_SPIN(xb_ld(&bar[XB_XGEN(b.x)]) == gen, bar);
            __builtin_amdgcn_fence(__ATOMIC_ACQUIRE, "agent");
            asm volatile("s_waitcnt vmcnt(0)" ::: "memory");
        }
    }
    __syncthreads();
}

__global__ void __launch_bounds__(512) mega(Params p) {
    extern __shared__ __attribute__((aligned(16))) unsigned char shm[];
    LAS unsigned char* lds = (LAS unsigned char*)shm;
    cg::grid_group grid = cg::this_grid();
    unsigned char* ws = p.ws;
    volatile LAS unsigned* xst = (volatile LAS unsigned*)(lds + 131072);
    if (threadIdx.x == 0) { xst[0] = 0u; xst[1] = 0u; }
    __syncthreads();
    XcdBarrier xb = xcd_barrier_post((unsigned*)(ws + WS_END), xst);
    const int G = gridDim.x;
    u64* SS = (u64*)(ws + WS_SS);
    bf16_t* XB = (bf16_t*)(ws + WS_XB);
    __builtin_amdgcn_fence(__ATOMIC_ACQUIRE, "agent");
    for (int ph = p.ph_lo; ph < p.ph_hi; ++ph) {
        int kind, li = 0, half = 0;
        if (ph == 0) kind = 0;
        else if (ph == NPH - 1) kind = 10;
        else {
            int q = ph - 1;
            if (q < 8) li = 0; else if (q < 15) { li = 1; q -= 8; } else if (q < 23) { li = 2; q -= 15; } else { li = 3; q -= 23; }
            const bool even = !(li & 1);
            if (q == 0) { kind = 1; half = 0; } else if (q == 1) { kind = 2; half = 0; }
            else if (even) { if (q < 6) kind = q + 1; else { kind = q - 5; half = 1; } }
            else { if (q < 5) kind = q + 5; else { kind = q - 4; half = 1; } }
        }
        const int e = li >> 1, f = li * 2 + half;
        pg8::StaticOrder S;
        if (kind == 0) phase_prep(p, lds);
        else if (kind == 1) {
            pg8::Gemm g{XB, (const bf16_t*)(ws + WS_WGU + f * SZ_WGU), NMT, 22, 1024, 1024, 0, 1024, 22, 0};
            unsigned* cnt = (unsigned*)(ws + WS_END + 16384) + 31 * 128 + f;
            pg8::EpiGU E{(bf16_t*)(ws + WS_P16), SS + (size_t)(3 * li + (half ? 2 : 0)) * M, (G == 256) ? cnt : nullptr};
            if (G == 256) S.init_f1(blockIdx.x); else S.init(g.nM, g.nN, G, blockIdx.x);
            pg8::gemm_phase(lds, g, S, E);
            if (G == 256 && blockIdx.x >= 248) {
                if (threadIdx.x == 0) { unsigned sp = 0; while (xb_ld(cnt) < 22u * 8u) { __builtin_amdgcn_s_sleep(2); if (++sp > (1u << 24)) break; } }
                __syncthreads();
                __builtin_amdgcn_fence(__ATOMIC_ACQUIRE, "agent");
                asm volatile("s_waitcnt vmcnt(0)" ::: "memory");
                pg8::EpiX EX; EX.X = p.out; EX.XB = XB; EX.scale = nullptr; EX.alpha = 0.5f; EX.ssn = SS + (size_t)(3 * li + (half ? 3 : 1)) * M;
                pg8::Gemm gs{(const bf16_t*)(ws + WS_P16), (const bf16_t*)(ws + WS_WD + f * SZ_WD), 1, 8, 1408, 2816, 0, 2816, 4, 64};
                pg8::EpiSplitX ES{EX, (float*)(ws + WS_E2G), (unsigned*)(ws + WS_END + 16384) + ph * 128, 4};
                S.init(1, 8, 8, blockIdx.x - 248); pg8::gemm_phase(lds, gs, S, ES);
            }
        } else if ((kind == 2 || kind == 6 || kind == 9)) {
            pg8::Gemm g; pg8::EpiX E; E.X = p.out; E.XB = XB; E.scale = nullptr;
            int NS = 0;
            if (kind == 2) { g = pg8::Gemm{(const bf16_t*)(ws + WS_P16), (const bf16_t*)(ws + WS_WD + f * SZ_WD), 64, 4, 2816, 2816, 0, 2816, 4, 0}; E.alpha = 0.5f; E.ssn = SS + (size_t)(3 * li + (half ? 3 : 1)) * M; NS = 2; }
            else if (kind == 6) { g = pg8::Gemm{(const bf16_t*)(ws + WS_OA), (const bf16_t*)(ws + WS_WOUT + e * SZ_W1K), NMT, 4, 1024, 1024, 0, 1024, 4, 0}; E.alpha = 1.f; E.ssn = SS + (size_t)(3 * li + 2) * M; }
            else { g = pg8::Gemm{(const bf16_t*)(ws + WS_P16 + (size_t)M * 1024 * 2), (const bf16_t*)(ws + WS_WGRP + e * SZ_WGRP), NMT, 4, 256, 1024, 256, 256, 4, 0}; E.alpha = 1.f; E.ssn = SS + (size_t)(3 * li + 2) * M; E.scale = p.in[16] + e * D; }
            S.init(g.nM, g.nN, G, blockIdx.x); pg8::gemm_phase(lds, g, S, E);
            if (NS && G != 256) {
                pg8::Gemm gs = g; gs.nM = 1; gs.nN = 4 * NS; gs.K = g.K / NS; gs.pm0 = 64;
                pg8::EpiSplitX ES{E, (float*)(ws + WS_E2G), (unsigned*)(ws + WS_END + 16384) + ph * 128, 4};
                S.init(gs.nM, gs.nN, G, blockIdx.x); pg8::gemm_phase(lds, gs, S, ES);
            }
        } else if (kind == 3) {
            const u64* ss = SS + (size_t)(3 * li + 1) * M;
            pg8::Gemm g{XB, (const bf16_t*)(ws + WS_WIN + e * SZ_WIN), NMT, 16, 1024, 1024, 0, 1024, 16, 0};
            pg8::EpiP E{(bf16_t*)(ws + WS_P16), (float*)(ws + WS_LOGG), ss, p.in[6], e};
            S.init(g.nM, g.nN, G, blockIdx.x); pg8::gemm_phase(lds, g, S, E);
            phase_ab(p, e, ss);
        } else if (kind == 4) {
            for (int it = blockIdx.x, k = 0; it < 2048; it += G, ++k) { if ((it + k) & 1) e2_gdn(p, lds, e, it >> 1); else e2_hgrn(p, lds, it >> 1); }
        } else if (kind == 5) {
            if (G > 64) {
                if (blockIdx.x < 64) { if (blockIdx.x & 1) e3_prompt<true>(p, lds, e, blockIdx.x >> 1); else e3_prompt<false>(p, lds, e, blockIdx.x >> 1); }
                else {
                    for (int s = blockIdx.x - 64; s < 1024; s += G - 64) e3_sample(p, lds, e, s & 1, s >> 1);
                    __syncthreads();
                    int tid2 = threadIdx.x; asm volatile("" : "+v"(tid2));
                    LAS float* scr = (LAS float*)(lds + (tid2 >> 6) * 8448);
                    const int worker = (blockIdx.x - 64) * 8 + (tid2 >> 6), nworkers = (G - 64) * 8;
                    if (li == 0) { convert_layer(p, scr, 1, worker, nworkers, tid2 & 63); convert_layer(p, scr, 2, worker, nworkers, tid2 & 63); }
                    else convert_layer(p, scr, 3, worker, nworkers, tid2 & 63);
                    __syncthreads();
                }
            } else {
                for (int it = blockIdx.x; it < 64; it += G) { if (it & 1) e3_prompt<true>(p, lds, e, it >> 1); else e3_prompt<false>(p, lds, e, it >> 1); }
                for (int s = blockIdx.x; s < 1024; s += G) e3_sample(p, lds, e, s & 1, s >> 1);
            }
        } else if (kind == 7) {
            pg8::Gemm g{XB, (const bf16_t*)(ws + WS_WP + e * SZ_W1K), NMT, 4, 1024, 1024, 0, 1024, 4, 0};
            pg8::EpiU E{(bf16_t*)(ws + WS_P16), SS + (size_t)(3 * li + 1) * M};
            S.init(g.nM, g.nN, G, blockIdx.x); pg8::gemm_phase(lds, g, S, E);
        } else if (kind == 8) phase_pool(p, e);
        else if (kind == 10) phase_final(p);
        if (ph + 1 < p.ph_hi) { if (p.ph_lo < 0) grid.sync(); else xcd_barrier(xb); }
    }
    __builtin_amdgcn_fence(__ATOMIC_RELEASE, "agent");
}

extern "C" void kernel_launch(void* const* d_in, const int* in_sizes, int n_in, void* d_out, int out_size, void* d_ws, size_t ws_size, hipStream_t stream) {
    static int grid = 0;
    if (grid == 0) {
        if (n_in != 27 || ws_size < WS_END + 32768) { fprintf(stderr, "kernel_launch: unexpected inputs (n_in %d, ws %zu, need %zu)\n", n_in, ws_size, (size_t)WS_END + 32768); grid = -1; return; }
        int dev = 0, cus = 0, per_cu = 0;
        (void)hipGetDevice(&dev); (void)hipDeviceGetAttribute(&cus, hipDeviceAttributeMultiprocessorCount, dev);
        (void)hipFuncSetAttribute((const void*)mega, hipFuncAttributeMaxDynamicSharedMemorySize, LDS_BYTES);
        (void)hipOccupancyMaxActiveBlocksPerMultiprocessor(&per_cu, (const void*)mega, 512, LDS_BYTES);
        (void)hipGetLastError();
        grid = cus;
    }
    if (grid < 0) return;
    Params p{};
    for (int i = 0; i < 27; ++i) p.in[i] = (const float*)d_in[i];
    p.out = (float*)d_out; p.ws = (unsigned char*)d_ws;
    (void)hipMemsetAsync((char*)d_ws + WS_END, 0, 32768, stream);
    p.ph_lo = 0; p.ph_hi = NPH;
    void* args[] = {&p};
    hipError_t e = hipLaunchCooperativeKernel((const void*)mega, dim3(grid), dim3(512), args, LDS_BYTES, stream);
    if (e != hipSuccess) fprintf(stderr, "cooperative launch failed: %s\n", hipGetErrorString(e));
}
```

```cpp
#include <hip/hip_runtime.h>
#include <hip/hip_cooperative_groups.h>
#include <cstdio>
namespace cg = cooperative_groups;


#define LAS __attribute__((address_space(3)))
typedef unsigned short bf16_t;
typedef short bf16x8 __attribute__((ext_vector_type(8)));
typedef float f32x4 __attribute__((ext_vector_type(4)));
typedef unsigned u32x4 __attribute__((ext_vector_type(4)));
typedef unsigned u32x2 __attribute__((ext_vector_type(2)));
typedef unsigned long long u64;
#define SS_RS(v) rsqrtf((float)(v) * (1.f / (16777216.f * 1024.f)) + EPS)

constexpr int D = 1024, FF = 2816, TP = 2048, NB = 8, MP = 16384, MS = 128, MR = 16512, M = 16640;
constexpr int NMT = M / 256;
constexpr float EPS = 1e-6f;
constexpr int NPH = 32;
constexpr int LDS_BYTES = 131072 + 16;

constexpr size_t SZ_WGU = (size_t)5632 * 1024 * 2, SZ_WD = (size_t)1024 * 2816 * 2, SZ_WIN = (size_t)4096 * 1024 * 2, SZ_W1K = (size_t)1024 * 1024 * 2, SZ_WGRP = (size_t)1024 * 256 * 2;
constexpr size_t WS_WGU = 0;
constexpr size_t WS_WD = WS_WGU + 8 * SZ_WGU;
constexpr size_t WS_WIN = WS_WD + 8 * SZ_WD;
constexpr size_t WS_WOUT = WS_WIN + 2 * SZ_WIN;
constexpr size_t WS_WP = WS_WOUT + 2 * SZ_W1K;
constexpr size_t WS_WGRP = WS_WP + 2 * SZ_W1K;
constexpr size_t WS_WAB = WS_WGRP + 2 * SZ_WGRP;
constexpr size_t WS_XB = WS_WAB + 2 * 8 * 1024 * 4;
constexpr size_t WS_SS = WS_XB + (size_t)M * 1024 * 2;
constexpr size_t WS_AB = WS_SS + (size_t)13 * M * 8;
constexpr size_t WS_OA = WS_AB + (size_t)M * 8 * 4;
constexpr size_t WS_LOGG = WS_OA + (size_t)M * 1024 * 2;
constexpr size_t WS_P16 = WS_LOGG + (size_t)M * 512 * 4;
constexpr size_t E2G_BYTES = 73984, E2H_BYTES = 57856;
constexpr size_t WS_E2G = WS_P16 + (size_t)M * 4096 * 2;
constexpr size_t WS_E2H = WS_E2G + 1024 * E2G_BYTES;
constexpr size_t WS_END = WS_E2H + 1024 * E2H_BYTES;

constexpr size_t O_Y = 0, O_HGP = 16908288, O_GDP = 17956864, O_CVP = 19005440, O_PLP = 19079168, O_HGS = 19324928, O_GDS = 36102144, O_CVS = 52879360, O_PLS = 54059008;

struct Params {
    const float* in[27];
    float* out;
    unsigned char* ws;
    int ph_lo, ph_hi;
};

typedef __bf16 bf16x2_t __attribute__((ext_vector_type(2)));
typedef float f32x2_t __attribute__((ext_vector_type(2)));
__device__ __forceinline__ unsigned pk2(float lo, float hi) { f32x2_t v = {lo, hi}; bf16x2_t b = __builtin_convertvector(v, bf16x2_t); return __builtin_bit_cast(unsigned, b); }
__device__ __forceinline__ bf16_t f2bf(float f) { return (bf16_t)(pk2(f, 0.f) & 0xffffu); }
__device__ __forceinline__ float bf2f(bf16_t b) { return __uint_as_float(((unsigned)b) << 16); }
__device__ __forceinline__ float bflo(unsigned w) { return __uint_as_float(w << 16); }
__device__ __forceinline__ float bfhi(unsigned w) { return __uint_as_float(w & 0xffff0000u); }
__device__ __forceinline__ float sigm(float x) { return __builtin_amdgcn_rcpf(1.f + __expf(-x)); }
__device__ __forceinline__ float silu(float x) { return x * sigm(x); }
__device__ __forceinline__ void unpack8(u32x4 a, float* x) { x[0] = bflo(a.x); x[1] = bfhi(a.x); x[2] = bflo(a.y); x[3] = bfhi(a.y); x[4] = bflo(a.z); x[5] = bfhi(a.z); x[6] = bflo(a.w); x[7] = bfhi(a.w); }
__device__ __forceinline__ u32x4 pack8(const float* x) { u32x4 r; r.x = pk2(x[0], x[1]); r.y = pk2(x[2], x[3]); r.z = pk2(x[4], x[5]); r.w = pk2(x[6], x[7]); return r; }
__device__ __forceinline__ float wave_sum(float v) {
#pragma unroll
    for (int o = 1; o < 64; o <<= 1) v += __shfl_xor(v, o);
    return v;
}
#define LDS_WAIT() asm volatile("s_waitcnt lgkmcnt(0)" ::: "memory")
__device__ __forceinline__ int fo_off(int R, int C, int KS) { return ((((R >> 4) * KS + (C >> 5)) * 64 + ((C >> 3) & 3) * 16 + (R & 15)) << 3) + (C & 7); }
__device__ __forceinline__ f32x4 mfma16(bf16x8 a, bf16x8 b, f32x4 c) { return __builtin_amdgcn_mfma_f32_16x16x32_bf16(a, b, c, 0, 0, 0); }

namespace pg8 {
constexpr int BM = 256, BK = 64, HALF = 128, HTB = HALF * BK * 2, NXCD = 8, WGM = 8;
__device__ __forceinline__ int lds_byte(int r, int c) { const int st = (r >> 4) * 2 + (c >> 5), rr = r & 15, cc = c & 31, ob = rr * 64 + cc * 2; return st * 1024 + (ob ^ (((ob >> 9) & 1) << 5)); }
__device__ __forceinline__ void stage_rc(int b, int& R, int& C) { const int st = b / 1024, sb = b % 1024, swz = sb ^ (((sb >> 9) & 1) << 5); R = (st >> 1) * 16 + swz / 64; C = (st & 1) * 32 + (swz % 64) / 2; }
__device__ __forceinline__ int perm32(int rho) { const int n = rho >> 4, i = rho & 15; return 8 * (i >> 2) + 4 * n + (i & 3); }
struct Unit { int pm, pn; };
struct Gemm { const bf16_t* A; const bf16_t* Bt; int nM, nN, K, lda, apn, ldb, nNr, pm0; };
struct StaticOrder {
    int nM, nN, nwg, G, c, mode;
    __device__ void init(int nM_, int nN_, int G_, int c_) { nM = nM_; nN = nN_; nwg = nM * nN; G = G_; c = c_; mode = 0; }
    __device__ void init_f1(int c_) { nM = 64; nN = 22; nwg = 1408; G = 256; c = c_; mode = 1; }
    __device__ bool next(int i, Unit& u) const {
        long L = (long)i * G + c;
        if (mode == 1) {
            if (c >= 248) { if (i >= 4) return false; }
            else if (c >= 150 && c < 158) { if (i == 5) L = 1024 + (c + 98); else if (i > 5) return false; }
            else if (L >= 1430) return false;
            if (L < 22) { u.pm = 64; u.pn = (int)L; return true; }
            L -= 22;
        }
        if (L >= nwg) return false;
        int wgid = (int)L; { const int q = nwg / NXCD, r = nwg % NXCD, xcd = wgid % NXCD, off = wgid / NXCD; wgid = (xcd < r ? xcd * (q + 1) : r * (q + 1) + (xcd - r) * q) + off; }
        const int nig = WGM * nN, gid = wgid / nig, fm = gid * WGM, gsz = (nM - fm) < WGM ? (nM - fm) : WGM;
        u.pm = fm + ((wgid % nig) % gsz); u.pn = (wgid % nig) / gsz; return true;
    }
};

template <class Epi>
__device__ __forceinline__ void gemm_phase(LAS unsigned char* lds, const Gemm g, const StaticOrder& S, const Epi& E) {
    int tid_ = threadIdx.x; asm volatile("" : "+v"(tid_));
    const int tid = tid_, wid = __builtin_amdgcn_readfirstlane(tid >> 6), lane = tid & 63, wr = wid >> 2, wc = wid & 3, fr = lane & 15, fq = lane >> 4;
    const int K = g.K, nt = K / BK;
    unsigned voffA[2], voffB[2];
#pragma unroll
    for (int i = 0; i < 2; ++i) { int R, C; stage_rc(tid * 16 + i * 8192, R, C); const int Rb = Epi::PERM ? ((R & ~31) + perm32(R & 31)) : R;
        voffA[i] = (unsigned)(R * g.lda + C) * 2u; voffB[i] = (unsigned)(Rb * g.ldb + C) * 2u; }
    const size_t kstep = (size_t)(BK * 2);
    const size_t hstepA = (size_t)HALF * g.lda * 2, hstepB = (size_t)HALF * g.ldb * 2;
    const size_t tstepA = 2 * hstepA, tstepB = 2 * hstepB;
    const unsigned ldsw = (unsigned)wid * 1024u;
    const int aoff = lds_byte(wr * 64 + fr, fq * 8), boff = lds_byte(wc * 32 + fr, fq * 8);
#define PG8_SA(b, h) (((b) * 2 + (h)) * HTB)
#define PG8_SB(b, h) ((4 + (b) * 2 + (h)) * HTB)
#define PG8_STAGE(bufoff, gbase, voff) do { _Pragma("unroll") for (int _i = 0; _i < 2; ++_i) \
        __builtin_amdgcn_global_load_lds((const unsigned*)((const char*)(gbase) + (voff)[_i]), (LAS unsigned*)(lds + (bufoff) + ldsw + _i * 8192), 16, 0, 0); } while (0)
#define PG8_LDA(dst, b, h) do { _Pragma("unroll") for (int m = 0; m < 4; ++m) _Pragma("unroll") for (int k = 0; k < 2; ++k) dst[m][k] = *(const LAS bf16x8*)(lds + PG8_SA(b, h) + aoff + m * 2048 + k * 1024); } while (0)
#define PG8_LDB(dst, b, h) do { _Pragma("unroll") for (int n = 0; n < 2; ++n) _Pragma("unroll") for (int k = 0; k < 2; ++k) dst[n][k] = *(const LAS bf16x8*)(lds + PG8_SB(b, h) + boff + n * 2048 + k * 1024); } while (0)
#define PG8_MMA(ai, bj, At, Bt) do { __builtin_amdgcn_s_setprio(1); _Pragma("unroll") for (int m = 0; m < 4; ++m) _Pragma("unroll") for (int n = 0; n < 2; ++n) _Pragma("unroll") for (int k = 0; k < 2; ++k) \
        acc[ai][bj][m][n] = __builtin_amdgcn_mfma_f32_16x16x32_bf16(Bt[n][k], At[m][k], acc[ai][bj][m][n], 0, 0, 0); __builtin_amdgcn_s_setprio(0); } while (0)
#define PG8_WAIT_V(n) asm volatile("s_waitcnt vmcnt(" #n ")" ::: "memory")
#define PG8_WAIT_L(n) asm volatile("s_waitcnt lgkmcnt(" #n ")" ::: "memory")
#define PG8_BAR __builtin_amdgcn_s_barrier()
#define PG8_SCHED __builtin_amdgcn_sched_barrier(0)
    Unit cur, nxt; int ui = 0;
    if (!S.next(0, cur)) return;
    f32x4 acc[2][2][4][2];
#pragma unroll
    for (int a = 0; a < 2; ++a)
#pragma unroll
        for (int b = 0; b < 2; ++b)
#pragma unroll
            for (int m = 0; m < 4; ++m)
#pragma unroll
                for (int n = 0; n < 2; ++n) acc[a][b][m][n] = (f32x4){0.f, 0.f, 0.f, 0.f};
    bf16x8 At[4][2], B0[2][2], B1[2][2];
#define PG8_ABASE(u) ((const char*)g.A + (size_t)((u).pm + g.pm0) * tstepA + ((size_t)((u).pn % g.nNr) * g.apn + (size_t)((u).pn / g.nNr) * K) * 2)
#define PG8_BBASE(u) ((const char*)g.Bt + (size_t)((u).pn % g.nNr) * tstepB + (size_t)((u).pn / g.nNr) * K * 2)
    const char* cA = PG8_ABASE(cur); const char* cB = PG8_BBASE(cur);
    PG8_STAGE(PG8_SB(0, 0), cB, voffB); PG8_STAGE(PG8_SA(0, 0), cA, voffA); PG8_STAGE(PG8_SB(0, 1), cB + hstepB, voffB); PG8_STAGE(PG8_SA(0, 1), cA + hstepA, voffA);
    if (wr == 1) PG8_BAR;
    PG8_WAIT_V(4); PG8_BAR;
    PG8_STAGE(PG8_SB(1, 0), cB + kstep, voffB); PG8_STAGE(PG8_SA(1, 0), cA + kstep, voffA); PG8_STAGE(PG8_SB(1, 1), cB + hstepB + kstep, voffB);
    PG8_WAIT_V(6); PG8_BAR;
    for (;;) {
        const bool has_next = S.next(ui + 1, nxt);
        const char* nA = has_next ? PG8_ABASE(nxt) : cA; const char* nB = has_next ? PG8_BBASE(nxt) : cB;
        for (int t = 0; t < nt; t += 2) {
            const bool last = (t == nt - 2);
            const char* a1 = cA + (size_t)(t + 1) * kstep;
            const char* a2 = last ? nA : cA + (size_t)(t + 2) * kstep; const char* b2 = last ? nB : cB + (size_t)(t + 2) * kstep;
            const char* a3 = a2 + kstep; const char* b3 = b2 + kstep;
            PG8_LDB(B0, 0, 0); PG8_SCHED; PG8_LDA(At, 0, 0); PG8_STAGE(PG8_SA(1, 1), a1 + hstepA, voffA);
            PG8_WAIT_L(8); PG8_BAR; PG8_WAIT_L(0); PG8_MMA(0, 0, At, B0); PG8_BAR; PG8_SCHED;
            PG8_LDB(B1, 0, 1); PG8_STAGE(PG8_SB(0, 0), b2, voffB);
            PG8_BAR; PG8_WAIT_L(0); PG8_MMA(0, 1, At, B1); PG8_BAR;
            PG8_LDA(At, 0, 1); PG8_STAGE(PG8_SA(0, 0), a2, voffA);
            PG8_BAR; PG8_WAIT_L(0); PG8_MMA(1, 0, At, B0); PG8_BAR; PG8_SCHED;
            PG8_STAGE(PG8_SB(0, 1), b2 + hstepB, voffB);
            PG8_WAIT_V(6); PG8_BAR; PG8_MMA(1, 1, At, B1); PG8_BAR;
            PG8_LDB(B0, 1, 0); PG8_SCHED; PG8_LDA(At, 1, 0); PG8_STAGE(PG8_SA(0, 1), a2 + hstepA, voffA);
            PG8_WAIT_L(8); PG8_BAR; PG8_WAIT_L(0); PG8_MMA(0, 0, At, B0); PG8_BAR; PG8_SCHED;
            PG8_LDB(B1, 1, 1); PG8_STAGE(PG8_SB(1, 0), b3, voffB);
            PG8_BAR; PG8_WAIT_L(0); PG8_MMA(0, 1, At, B1); PG8_BAR;
            PG8_LDA(At, 1, 1); PG8_STAGE(PG8_SA(1, 0), a3, voffA);
            PG8_BAR; PG8_WAIT_L(0); PG8_MMA(1, 0, At, B0); PG8_BAR; PG8_SCHED;
            PG8_STAGE(PG8_SB(1, 1), b3 + hstepB, voffB);
            PG8_WAIT_V(6); PG8_BAR; PG8_MMA(1, 1, At, B1); PG8_BAR;
        }
        { Unit eu; eu.pm = cur.pm + g.pm0; eu.pn = cur.pn; E(acc, eu, wr, wc, fr, fq); }
        if (!has_next) break;
#pragma unroll
        for (int a = 0; a < 2; ++a)
#pragma unroll
            for (int b = 0; b < 2; ++b)
#pragma unroll
                for (int m = 0; m < 4; ++m)
#pragma unroll
                    for (int n = 0; n < 2; ++n) acc[a][b][m][n] = (f32x4){0.f, 0.f, 0.f, 0.f};
        cur = nxt; cA = nA; cB = nB; ++ui;
    }
    PG8_WAIT_V(0);
    if (wr == 0) PG8_BAR;
    PG8_BAR;
#undef PG8_ABASE
#undef PG8_BBASE
#undef PG8_SA
#undef PG8_SB
#undef PG8_STAGE
#undef PG8_LDA
#undef PG8_LDB
#undef PG8_MMA
#undef PG8_WAIT_V
#undef PG8_WAIT_L
#undef PG8_BAR
#undef PG8_SCHED
}

struct EpiGU {
    static constexpr bool PERM = true;
    bf16_t* ACT; const u64* ss; unsigned* cnt;
    __device__ __forceinline__ void operator()(const f32x4 (&acc)[2][2][4][2], const Unit& u, int wr, int wc, int fr, int fq) const {
        const int row0 = u.pm * BM + wr * 64 + fr, col0 = u.pn * 128 + wc * 32 + 8 * fq;
        if (cnt && u.pm == 64) {
            const __amdgpu_buffer_rsrc_t rsrc = __builtin_amdgcn_make_buffer_rsrc(ACT, 0, M * FF * 2, 0x00020000);
#pragma unroll
            for (int m = 0; m < 4; ++m) {
                const int r = row0 + m * 16; const float rs = SS_RS(ss[r]);
                float o[8];
#pragma unroll
                for (int n = 0; n < 2; ++n)
#pragma unroll
                    for (int j = 0; j < 4; ++j) { const float gg = acc[0][0][m][n][j] * rs, uu = acc[0][1][m][n][j] * rs; o[4 * n + j] = silu(gg) * uu; }
                __builtin_amdgcn_raw_buffer_store_b128(pack8(o), rsrc, (unsigned)(((size_t)r * FF + col0) * 2), 0, 16);
            }
            asm volatile("s_waitcnt vmcnt(0)" ::: "memory");
            if (fr == 0 && fq == 0) (void)__hip_atomic_fetch_add(cnt, 1u, __ATOMIC_RELAXED, __HIP_MEMORY_SCOPE_AGENT);
            return;
        }
        u64 sv[2][4]; float rsv[2][4];
#pragma unroll
        for (int ai = 0; ai < 2; ++ai)
#pragma unroll
            for (int m = 0; m < 4; ++m) sv[ai][m] = ss[row0 + ai * HALF + m * 16];
#pragma unroll
        for (int ai = 0; ai < 2; ++ai)
#pragma unroll
            for (int m = 0; m < 4; ++m) rsv[ai][m] = SS_RS(sv[ai][m]);
#pragma unroll
        for (int ai = 0; ai < 2; ++ai)
#pragma unroll
            for (int m = 0; m < 4; ++m) {
                const int r = row0 + ai * HALF + m * 16; const float rs = rsv[ai][m];
                float o[8];
#pragma unroll
                for (int n = 0; n < 2; ++n)
#pragma unroll
                    for (int j = 0; j < 4; ++j) { const float gg = acc[ai][0][m][n][j] * rs, uu = acc[ai][1][m][n][j] * rs; o[4 * n + j] = silu(gg) * uu; }
                *(u32x4*)(ACT + (size_t)r * FF + col0) = pack8(o);
            }
    }
};
struct EpiX {
    static constexpr bool PERM = true;
    float* X; bf16_t* XB; u64* ssn; const float* scale; float alpha;
    __device__ __forceinline__ void operator()(const f32x4 (&acc)[2][2][4][2], const Unit& u, int wr, int wc, int fr, int fq) const {
        const int row0 = u.pm * BM + wr * 64 + fr, col0 = u.pn * BM + wc * 32 + 8 * fq;
#pragma unroll
        for (int ai = 0; ai < 2; ++ai)
#pragma unroll
            for (int mp = 0; mp < 4; mp += 2) {
                f32x4 xv[2][2][2];
#pragma unroll
                for (int mm = 0; mm < 2; ++mm)
#pragma unroll
                    for (int bj = 0; bj < 2; ++bj) { const float* xp = X + (size_t)(row0 + ai * HALF + (mp + mm) * 16) * D + col0 + bj * HALF; xv[mm][bj][0] = *(const f32x4*)xp; xv[mm][bj][1] = *(const f32x4*)(xp + 4); }
#pragma unroll
                for (int mm = 0; mm < 2; ++mm) {
                    const int m = mp + mm;
                    const int r = row0 + ai * HALF + m * 16; const bool ok = r < MR; float sq = 0.f;
#pragma unroll
                    for (int bj = 0; bj < 2; ++bj) {
                        const int c = col0 + bj * HALF; float* xp = X + (size_t)r * D + c;
                        f32x4 y0 = acc[ai][bj][m][0] * alpha, y1 = acc[ai][bj][m][1] * alpha;
                        if (scale) { y0 = y0 * *(const f32x4*)(scale + c); y1 = y1 * *(const f32x4*)(scale + c + 4); }
                        const f32x4 x0 = xv[mm][bj][0] + y0, x1 = xv[mm][bj][1] + y1;
                        if (ok) {
                            *(f32x4*)xp = x0; *(f32x4*)(xp + 4) = x1;
                            u32x4 w; w.x = pk2(x0.x, x0.y); w.y = pk2(x0.z, x0.w); w.z = pk2(x1.x, x1.y); w.w = pk2(x1.z, x1.w);
                            *(u32x4*)(XB + (size_t)r * D + c) = w;
                            sq += (x0.x * x0.x + x0.y * x0.y) + (x0.z * x0.z + x0.w * x0.w) + (x1.x * x1.x + x1.y * x1.y) + (x1.z * x1.z + x1.w * x1.w);
                        }
                    }
                    sq += __shfl_xor(sq, 16); sq += __shfl_xor(sq, 32);
                    if (ok && fq == 0) atomicAdd(ssn + r, (u64)(sq * 16777216.f + 0.5f));
                }
            }
    }
};
struct EpiSplitX {
    static constexpr bool PERM = true;
    EpiX inner; float* part; unsigned* tick; int nNr;
    __device__ __forceinline__ void operator()(const f32x4 (&acc)[2][2][4][2], const Unit& u, int wr, int wc, int fr, int fq) const {
        const int pn_r = u.pn % nNr, ks = u.pn / nNr, wave = wr * 4 + wc, lane = fq * 16 + fr;
        const __amdgpu_buffer_rsrc_t rsrc = __builtin_amdgcn_make_buffer_rsrc(part, 0, 4 * 2 * 8 * 16 * 256 * 4, 0x00020000);
        const unsigned moff = (unsigned)((((pn_r * 2 + ks) * 8 + wave) * 16) * 256 + lane * 4) * 4u;
#pragma unroll
        for (int bj = 0; bj < 2; ++bj)
#pragma unroll
            for (int m = 0; m < 4; ++m)
#pragma unroll
                for (int n = 0; n < 2; ++n) __builtin_amdgcn_raw_buffer_store_b128(__builtin_bit_cast(u32x4, acc[0][bj][m][n]), rsrc, moff + (unsigned)(((bj * 4 + m) * 2 + n) * 1024), 0, 16);
        asm volatile("s_waitcnt vmcnt(0)" ::: "memory");
        unsigned old = 0u;
        if (lane == 0) old = __hip_atomic_fetch_add(tick + pn_r * 8 + wave, 1u, __ATOMIC_RELAXED, __HIP_MEMORY_SCOPE_AGENT);
        old = (unsigned)__builtin_amdgcn_readfirstlane((int)old);
        if (old == 1u) {
            __builtin_amdgcn_fence(__ATOMIC_ACQUIRE, "agent");
            asm volatile("s_waitcnt vmcnt(0)" ::: "memory");
            const float* src = part + ((size_t)((pn_r * 2 + (ks ^ 1)) * 8 + wave) * 16) * 256 + lane * 4;
            f32x4 sum[2][2][4][2];
#pragma unroll
            for (int bj = 0; bj < 2; ++bj)
#pragma unroll
                for (int m = 0; m < 4; ++m)
#pragma unroll
                    for (int n = 0; n < 2; ++n) { sum[0][bj][m][n] = acc[0][bj][m][n] + *(const f32x4*)(src + (((bj * 4 + m) * 2 + n) * 256)); sum[1][bj][m][n] = (f32x4){0.f, 0.f, 0.f, 0.f}; }
            Unit iu; iu.pm = u.pm; iu.pn = pn_r;
            inner(sum, iu, wr, wc, fr, fq);
        }
    }
};
struct EpiP {
    static constexpr bool PERM = true;
    bf16_t* P16; float* LOGG; const u64* ss; const float* lbraw; int e;
    template <int MODE>
    __device__ __forceinline__ void run(const f32x4 (&acc)[2][2][4][2], int row0, int col0) const {
        u64 sv[2][4]; float rsv[2][4];
#pragma unroll
        for (int ai = 0; ai < 2; ++ai)
#pragma unroll
            for (int m = 0; m < 4; ++m) sv[ai][m] = ss[row0 + ai * HALF + m * 16];
#pragma unroll
        for (int ai = 0; ai < 2; ++ai)
#pragma unroll
            for (int m = 0; m < 4; ++m) rsv[ai][m] = SS_RS(sv[ai][m]);
#pragma unroll
        for (int ai = 0; ai < 2; ++ai) {
#pragma unroll
            for (int m = 0; m < 4; ++m) {
                const int r = row0 + ai * HALF + m * 16; const float rs = rsv[ai][m];
#pragma unroll
                for (int bj = 0; bj < 2; ++bj) {
                    const int c = col0 + bj * HALF; float v[8];
#pragma unroll
                    for (int n = 0; n < 2; ++n) {
#pragma unroll
                        for (int j = 0; j < 4; ++j) v[4 * n + j] = acc[ai][bj][m][n][j] * rs;
                    }
                    if (MODE == 0) {
#pragma unroll
                        for (int i = 0; i < 8; ++i) v[i] = silu(v[i]) * 0.08838834764831845f;
                    }
                    if (MODE == 1) {
                        const int ch = c - 512; float lg[8];
                        const f32x4 l0a = *(const f32x4*)(lbraw + ch), l0b = *(const f32x4*)(lbraw + ch + 4), l1a = *(const f32x4*)(lbraw + 512 + ch), l1b = *(const f32x4*)(lbraw + 512 + ch + 4);
                        const float dl[8] = {l0a.x - l1a.x, l0a.y - l1a.y, l0a.z - l1a.z, l0a.w - l1a.w, l0b.x - l1b.x, l0b.y - l1b.y, l0b.z - l1b.z, l0b.w - l1b.w};
#pragma unroll
                        for (int i = 0; i < 8; ++i) {
                            const float x = v[i];
                            const float lsg = fminf(x, 0.f) - __logf(1.f + __expf(-fabsf(x)));
                            const float sg = __expf(lsg);
                            const float lb = (e == 0) ? 0.f : __builtin_amdgcn_rcpf(1.f + __expf(dl[i]));
                            const float gg = lb + (1.f - lb) * sg;
                            lg[i] = (e == 0) ? lsg : __logf(gg); v[i] = 1.f - gg;
                        }
                        float* lp = LOGG + (size_t)r * 512 + ch;
                        *(f32x4*)lp = (f32x4){lg[0], lg[1], lg[2], lg[3]}; *(f32x4*)(lp + 4) = (f32x4){lg[4], lg[5], lg[6], lg[7]};
                    }
                    *(u32x4*)(P16 + (size_t)r * 4096 + c) = pack8(v);
                }
            }
        }
    }
    __device__ __forceinline__ void operator()(const f32x4 (&acc)[2][2][4][2], const Unit& u, int wr, int wc, int fr, int fq) const {
        const int row0 = u.pm * BM + wr * 64 + fr, col0 = u.pn * BM + wc * 32 + 8 * fq;
        const int region = u.pn >> 1;
        if (region == 0) run<0>(acc, row0, col0); else if (region == 1) run<1>(acc, row0, col0); else run<2>(acc, row0, col0);
    }
};
struct EpiU {
    static constexpr bool PERM = true;
    bf16_t* U; const u64* ss;
    __device__ __forceinline__ void operator()(const f32x4 (&acc)[2][2][4][2], const Unit& u, int wr, int wc, int fr, int fq) const {
        const int row0 = u.pm * BM + wr * 64 + fr, col0 = u.pn * BM + wc * 32 + 8 * fq;
        u64 sv[2][4]; float rsv[2][4];
#pragma unroll
        for (int ai = 0; ai < 2; ++ai)
#pragma unroll
            for (int m = 0; m < 4; ++m) sv[ai][m] = ss[row0 + ai * HALF + m * 16];
#pragma unroll
        for (int ai = 0; ai < 2; ++ai)
#pragma unroll
            for (int m = 0; m < 4; ++m) rsv[ai][m] = SS_RS(sv[ai][m]);
#pragma unroll
        for (int ai = 0; ai < 2; ++ai)
#pragma unroll
            for (int m = 0; m < 4; ++m) {
                const int r = row0 + ai * HALF + m * 16; const float rs = rsv[ai][m];
#pragma unroll
                for (int bj = 0; bj < 2; ++bj) {
                    float v[8];
#pragma unroll
                    for (int n = 0; n < 2; ++n)
#pragma unroll
                        for (int j = 0; j < 4; ++j) v[4 * n + j] = acc[ai][bj][m][n][j] * rs;
                    *(u32x4*)(U + (size_t)r * D + col0 + bj * HALF) = pack8(v);
                }
            }
    }
};
}

__device__ __forceinline__ void tr_item(const float* W, int ldw, const float* nw, bf16_t* WT, int ldk, int k0, int nsrc0, int rowdst0, LAS float* scr, int lane) {
#pragma unroll
    for (int i = 0; i < 32; ++i) { const int kk = 2 * i + (lane >> 5); const float s = nw ? nw[k0 + kk] : 1.f; scr[kk * 33 + (lane & 31)] = __builtin_nontemporal_load(W + (size_t)(k0 + kk) * ldw + nsrc0 + (lane & 31)) * s; }
    LDS_WAIT();
    const int c = lane & 7;
#pragma unroll
    for (int j = 0; j < 4; ++j) { const int n = (lane >> 3) + 8 * j; const LAS float* s = scr + (8 * c) * 33 + n;
        u32x4 o; o.x = pk2(s[0 * 33], s[1 * 33]); o.y = pk2(s[2 * 33], s[3 * 33]); o.z = pk2(s[4 * 33], s[5 * 33]); o.w = pk2(s[6 * 33], s[7 * 33]);
        *(u32x4*)(WT + (size_t)(rowdst0 + n) * ldk + k0 + 8 * c) = o; }
    LDS_WAIT();
}

__device__ __forceinline__ void convert_layer(const Params& p, LAS float* scr, int li, int worker, int nworkers, int lane) {
    unsigned char* ws = p.ws;
    const int nmix = (li & 1) ? 640 : 2560, total = 8448 + nmix;
    for (int it = worker; it < total; it += nworkers) {
        if (it < 8448) {
            const int idx = it / 1408, rr = it % 1408, which = idx / 3, mat = idx % 3, f = li * 2 + which;
            if (mat < 2) {
                const float* W = p.in[which ? (mat ? 24 : 23) : (mat ? 19 : 18)] + (size_t)li * D * FF;
                const float* nw = p.in[which ? 22 : 17] + li * D;
                const int kb = rr / 88, nb = rr % 88, n0 = nb * 32;
                tr_item(W, FF, nw, (bf16_t*)(ws + WS_WGU + f * SZ_WGU), D, kb * 64, n0, 256 * (n0 >> 7) + (mat ? 128 : 0) + (n0 & 127), scr, lane);
            } else {
                const float* W = p.in[which ? 25 : 20] + (size_t)li * FF * D;
                const int kb = rr / 32, nb = rr % 32;
                tr_item(W, D, nullptr, (bf16_t*)(ws + WS_WD + f * SZ_WD), FF, kb * 64, nb * 32, nb * 32, scr, lane);
            }
        } else if (!(li & 1)) {
            const int e = li >> 1; int rr = it - 8448;
            if (rr < 2048) { const int kb = rr / 128, nb = rr % 128;
                tr_item(p.in[7] + (size_t)e * D * 4104, 4104, p.in[21] + (2 * e) * D, (bf16_t*)(ws + WS_WIN + e * SZ_WIN), D, kb * 64, nb * 32, nb * 32, scr, lane);
            } else { rr -= 2048; const int kb = rr / 32, nb = rr % 32;
                tr_item(p.in[13] + (size_t)e * D * D, D, nullptr, (bf16_t*)(ws + WS_WOUT + e * SZ_W1K), D, kb * 64, nb * 32, nb * 32, scr, lane); }
        } else {
            const int o = li >> 1; int rr = it - 8448;
            if (rr < 512) { const int kb = rr / 32, nb = rr % 32;
                tr_item(p.in[14] + (size_t)o * D * D, D, p.in[21] + (2 * o + 1) * D, (bf16_t*)(ws + WS_WP + o * SZ_W1K), D, kb * 64, nb * 32, nb * 32, scr, lane);
            } else { rr -= 512; const int gq = rr / 32, r2 = rr % 32, kb = r2 / 8, nb = r2 % 8;
                tr_item(p.in[15] + (size_t)(o * 4 + gq) * 65536, 256, nullptr, (bf16_t*)(ws + WS_WGRP + o * SZ_WGRP), 256, kb * 64, nb * 32, gq * 256 + nb * 32, scr, lane); }
        }
    }
    if (!(li & 1)) {
        const int e = li >> 1; float* WAB = (float*)(ws + WS_WAB) + e * 8192;
        for (int i = worker * 64 + lane; i < 8192; i += nworkers * 64) { const int j = i >> 10, k = i & 1023; WAB[i] = p.in[7][(size_t)e * D * 4104 + (size_t)k * 4104 + 4096 + j] * p.in[21][(2 * e) * D + k]; }
    }
}

__device__ __forceinline__ void phase_prep(const Params& p, LAS unsigned char* lds) {
    int tid_ = threadIdx.x; asm volatile("" : "+v"(tid_));
    { unsigned lb_ = (unsigned)(size_t)lds; asm volatile("" : "+v"(lb_)); lds = (LAS unsigned char*)(size_t)lb_; }
    const int tid = tid_, lane = tid & 63, wave = tid >> 6;
    const int gw = blockIdx.x * 8 + wave, NGW = gridDim.x * 8;
    unsigned char* ws = p.ws;
    LAS float* scr = (LAS float*)(lds + wave * 8448);
    convert_layer(p, scr, 0, gw, NGW, lane);
    if (gridDim.x <= 64) { for (int li = 1; li < 4; ++li) convert_layer(p, scr, li, gw, NGW, lane); }
    const int gt = blockIdx.x * 512 + tid, NGT = gridDim.x * 512;
    u64* SS = (u64*)(ws + WS_SS);
    for (int i = gt; i < 12 * M; i += NGT) SS[M + i] = 0ull;
    for (int i = gt; i < M - MR; i += NGT) SS[MR + i] = 0ull;
    bf16_t* XB = (bf16_t*)(ws + WS_XB);
    for (int r = gw; r < M; r += NGW) {
        if (r < MR) {
            const float* src = (r < MP) ? p.in[0] + (size_t)r * D : p.in[1] + (size_t)(r - MP) * D;
            float* dst = p.out + (size_t)r * D; float s = 0.f;
#pragma unroll
            for (int j = 0; j < 4; ++j) { const int c = 4 * lane + 256 * j; const f32x4 v = *(const f32x4*)(src + c); *(f32x4*)(dst + c) = v;
                u32x2 w; w.x = pk2(v.x, v.y); w.y = pk2(v.z, v.w); *(u32x2*)(XB + (size_t)r * D + c) = w; s += (v.x * v.x + v.y * v.y) + (v.z * v.z + v.w * v.w); }
            s = wave_sum(s); if (lane == 0) SS[r] = (u64)(s * 16777216.f + 0.5f);
        } else {
#pragma unroll
            for (int j = 0; j < 4; ++j) { const int c = 4 * lane + 256 * j; *(u32x2*)(XB + (size_t)r * D + c) = (u32x2){0u, 0u}; }
        }
    }
}

__device__ __forceinline__ void phase_ab(const Params& p, int e, const u64* ss) {
    int tid_ = threadIdx.x; asm volatile("" : "+v"(tid_));
    const int tid = tid_, lane = tid & 63, wave = tid >> 6;
    const int skip = (gridDim.x == 256) ? 16 : 0;
    if ((int)blockIdx.x < skip) return;
    const int gw = ((int)blockIdx.x - skip) * 8 + wave, NGW = ((int)gridDim.x - skip) * 8;
    const bf16_t* XB = (const bf16_t*)(p.ws + WS_XB); const float* WAB = (const float*)(p.ws + WS_WAB) + e * 8 * 1024; float* AB = (float*)(p.ws + WS_AB);
    for (int r = gw; r < MR; r += NGW) {
        float x[16]; const bf16_t* xp = XB + (size_t)r * D + 16 * lane;
        unpack8(*(const u32x4*)xp, x); unpack8(*(const u32x4*)(xp + 8), x + 8);
        const float rs = SS_RS(ss[r]);
        float sj[8];
#pragma unroll
        for (int j = 0; j < 8; ++j) {
            const float* w = WAB + j * 1024 + 16 * lane; float s = 0.f;
#pragma unroll
            for (int i = 0; i < 4; ++i) { const f32x4 wv = *(const f32x4*)(w + 4 * i); s += x[4 * i] * wv.x + x[4 * i + 1] * wv.y + x[4 * i + 2] * wv.z + x[4 * i + 3] * wv.w; }
            sj[j] = s;
        }
#pragma unroll
        for (int j = 0; j < 8; ++j) sj[j] = wave_sum(sj[j]) * rs;
        if (lane == 0) { float* ap = AB + (size_t)r * 8; *(f32x4*)ap = (f32x4){sj[0], sj[1], sj[2], sj[3]}; *(f32x4*)(ap + 4) = (f32x4){sj[4], sj[5], sj[6], sj[7]}; }
    }
}

__device__ __forceinline__ void e2_gdn(const Params& p, LAS unsigned char* lds, int e, int item) {
    int tid_ = threadIdx.x; asm volatile("" : "+v"(tid_));
    { unsigned lb_ = (unsigned)(size_t)lds; asm volatile("" : "+v"(lb_)); lds = (LAS unsigned char*)(size_t)lb_; }
    const int tid = tid_, lane = tid & 63, wave = tid >> 6, fr = lane & 15, fq = lane >> 4;
    const int seq = item >> 5, n = item & 31, b = seq >> 2, h = seq & 3;
    const int t = tid >> 3, sub = tid & 7, c0 = sub * 16;
    const int tpos = n * 64 + t; const size_t r = (size_t)b * TP + tpos;
    LAS bf16_t* Qs = (LAS bf16_t*)(lds); LAS bf16_t* Ks = (LAS bf16_t*)(lds + 17408); LAS bf16_t* KBT = (LAS bf16_t*)(lds + 34816); LAS bf16_t* VBT = (LAS bf16_t*)(lds + 53248);
    LAS bf16_t* Tm = (LAS bf16_t*)(lds + 71680); LAS float* Af = (LAS float*)(lds + 80896); LAS float* gv = (LAS float*)(lds + 98304); LAS float* bv = gv + 64; LAS float* btv = gv + 128;
    const bf16_t* P16 = (const bf16_t*)(p.ws + WS_P16); const float* AB = (const float*)(p.ws + WS_AB);
    unsigned char* blk = p.ws + WS_E2G + (size_t)item * E2G_BYTES;
    bf16_t* uT = (bf16_t*)blk; bf16_t* wF = (bf16_t*)(blk + 16384); bf16_t* qF = (bf16_t*)(blk + 32768); bf16_t* kF = (bf16_t*)(blk + 49152); bf16_t* aF = (bf16_t*)(blk + 65536); float* dec = (float*)(blk + 73728);
    if (sub == 0) {
        const float a = AB[r * 8 + h], bb = AB[r * 8 + 4 + h];
        const float Ah = __expf(p.in[10][e * 4 + h]); const float x = a + p.in[11][e * 4 + h];
        const float sp = x > 20.f ? x : log1pf(__expf(x));
        gv[t] = -Ah * sp; btv[t] = sigm(bb);
    }
    float qv[16], kv[16], vv[16];
    const float* cw = p.in[9] + (size_t)e * 4 * 1536;
#pragma unroll
    for (int part = 0; part < 3; ++part) {
        float a[16];
#pragma unroll
        for (int i = 0; i < 16; ++i) a[i] = 0.f;
        const int ch = part * 512 + h * 128 + c0;
        if (n > 0) {
#pragma unroll
        for (int j = 0; j < 4; ++j) {
            {
                const bf16_t* src = P16 + (r - 3 + j) * 4096 + 2048 + ch; float x[16];
                unpack8(*(const u32x4*)src, x); unpack8(*(const u32x4*)(src + 8), x + 8);
                const float* w = cw + j * 1536 + ch;
#pragma unroll
                for (int i = 0; i < 4; ++i) { const f32x4 wv = *(const f32x4*)(w + 4 * i); a[4 * i] += x[4 * i] * wv.x; a[4 * i + 1] += x[4 * i + 1] * wv.y; a[4 * i + 2] += x[4 * i + 2] * wv.z; a[4 * i + 3] += x[4 * i + 3] * wv.w; }
                if (j == 3 && n == 31 && t >= 61) {
                    float* o = p.out + O_CVP + ((size_t)(e * NB + b) * 3 + (t - 61)) * 1536 + ch;
#pragma unroll
                    for (int i = 0; i < 4; ++i) *(f32x4*)(o + 4 * i) = (f32x4){x[4 * i], x[4 * i + 1], x[4 * i + 2], x[4 * i + 3]};
                }
            }
        }
        } else {
#pragma unroll
        for (int j = 0; j < 4; ++j) {
            if (tpos - 3 + j >= 0) {
                const bf16_t* src = P16 + (r - 3 + j) * 4096 + 2048 + ch; float x[16];
                unpack8(*(const u32x4*)src, x); unpack8(*(const u32x4*)(src + 8), x + 8);
                const float* w = cw + j * 1536 + ch;
#pragma unroll
                for (int i = 0; i < 4; ++i) { const f32x4 wv = *(const f32x4*)(w + 4 * i); a[4 * i] += x[4 * i] * wv.x; a[4 * i + 1] += x[4 * i + 1] * wv.y; a[4 * i + 2] += x[4 * i + 2] * wv.z; a[4 * i + 3] += x[4 * i + 3] * wv.w; }
                if (j == 3 && n == 31 && t >= 61) {
                    float* o = p.out + O_CVP + ((size_t)(e * NB + b) * 3 + (t - 61)) * 1536 + ch;
#pragma unroll
                    for (int i = 0; i < 4; ++i) *(f32x4*)(o + 4 * i) = (f32x4){x[4 * i], x[4 * i + 1], x[4 * i + 2], x[4 * i + 3]};
                }
            }
        }
        }
#pragma unroll
        for (int i = 0; i < 16; ++i) { const float s = silu(a[i]); if (part == 0) qv[i] = s; else if (part == 1) kv[i] = s; else vv[i] = s; }
    }
    float qs = 0.f, ks = 0.f;
#pragma unroll
    for (int i = 0; i < 16; ++i) { qs += qv[i] * qv[i]; ks += kv[i] * kv[i]; }
    qs += __shfl_xor(qs, 1); qs += __shfl_xor(qs, 2); qs += __shfl_xor(qs, 4);
    ks += __shfl_xor(ks, 1); ks += __shfl_xor(ks, 2); ks += __shfl_xor(ks, 4);
    const float qn = rsqrtf(qs + EPS) * 0.08838834764831845f, kn = rsqrtf(ks + EPS);
    __syncthreads();
    if (wave == 0) {
        float x = gv[lane];
#pragma unroll
        for (int o = 1; o < 64; o <<= 1) { const float y = __shfl_up(x, o); if (lane >= o) x += y; }
        bv[lane] = x;
    }
    __syncthreads();
    const float bt = bv[t], bl = bv[63];
    const float beta = btv[t], ebt = __expf(bt), ekl = __expf(bl - bt);
    if (tid == 0) dec[0] = __expf(bl);
    {
        float tq[16], tk[16], tqq[16];
#pragma unroll
        for (int i = 0; i < 16; ++i) { tq[i] = qv[i] * qn; tk[i] = kv[i] * kn; tqq[i] = tq[i] * ebt; }
        *(LAS u32x4*)(Qs + t * 136 + c0) = pack8(tq); *(LAS u32x4*)(Qs + t * 136 + c0 + 8) = pack8(tq + 8);
        *(LAS u32x4*)(Ks + t * 136 + c0) = pack8(tk); *(LAS u32x4*)(Ks + t * 136 + c0 + 8) = pack8(tk + 8);
        *(u32x4*)(qF + fo_off(t, c0, 4)) = pack8(tqq); *(u32x4*)(qF + fo_off(t, c0 + 8, 4)) = pack8(tqq + 8);
#pragma unroll
        for (int i = 0; i < 16; ++i) {
            KBT[(c0 + i) * 72 + t] = f2bf(tk[i] * beta * ebt);
            VBT[(c0 + i) * 72 + t] = f2bf(vv[i] * beta);
            kF[fo_off(c0 + i, t, 2)] = f2bf(tk[i] * ekl);
        }
    }
    __syncthreads();
#pragma unroll
    for (int q2 = 0; q2 < 2; ++q2) {
        const int id = 2 * wave + q2, mt = id >> 2, nt = id & 3;
        f32x4 a1 = {0.f, 0.f, 0.f, 0.f}, a2 = {0.f, 0.f, 0.f, 0.f};
#pragma unroll
        for (int ks4 = 0; ks4 < 4; ++ks4) {
            const bf16x8 km = *(const LAS bf16x8*)(Ks + (16 * mt + fr) * 136 + 32 * ks4 + 8 * fq);
            const bf16x8 kn2 = *(const LAS bf16x8*)(Ks + (16 * nt + fr) * 136 + 32 * ks4 + 8 * fq);
            const bf16x8 qn2 = *(const LAS bf16x8*)(Qs + (16 * nt + fr) * 136 + 32 * ks4 + 8 * fq);
            a1 = mfma16(km, kn2, a1);
            a2 = mfma16(km, qn2, a2);
        }
        {
            const int s = 16 * nt + fr; const float bs = bv[s];
#pragma unroll
            for (int j = 0; j < 4; ++j) { const int tt = 16 * mt + 4 * fq + j; Af[tt * 68 + s] = (s < tt) ? btv[tt] * a1[j] * __expf(bv[tt] - bs) : 0.f; }
        }
        {
            const int tt = 16 * nt + fr; const float btt = bv[tt]; float o[4];
#pragma unroll
            for (int j = 0; j < 4; ++j) { const int s = 16 * mt + 4 * fq + j; o[j] = (s <= tt) ? a2[j] * __expf(btt - bv[s]) : 0.f; }
            u32x2 w; w.x = pk2(o[0], o[1]); w.y = pk2(o[2], o[3]);
            *(u32x2*)(aF + fo_off(tt, 16 * mt + 4 * fq, 2)) = w;
        }
    }
    __syncthreads();
    if (wave == 0) {
        float Tc[64];
#pragma unroll
        for (int i = 0; i < 64; ++i) Tc[i] = 0.f;
#pragma unroll
        for (int tt = 1; tt < 64; ++tt) {
            float s0 = -Af[tt * 68 + lane], s1 = 0.f, s2 = 0.f, s3 = 0.f;
#pragma unroll
            for (int s4 = 0; s4 < (tt + 3) / 4; ++s4) {
                const f32x4 av = *(const LAS f32x4*)(Af + tt * 68 + 4 * s4);
                s0 -= av.x * Tc[4 * s4]; s1 -= av.y * Tc[4 * s4 + 1]; s2 -= av.z * Tc[4 * s4 + 2]; s3 -= av.w * Tc[4 * s4 + 3];
            }
            Tc[tt] = (s0 + s1) + (s2 + s3);
        }
#pragma unroll
        for (int tt = 0; tt < 64; ++tt) Tm[tt * 72 + lane] = f2bf(Tc[tt]);
        LDS_WAIT();
        Tm[lane * 72 + lane] = (bf16_t)0x3F80;
    }
    __syncthreads();
#pragma unroll
    for (int mt = 0; mt < 4; ++mt) {
        f32x4 a = {0.f, 0.f, 0.f, 0.f};
#pragma unroll
        for (int k2 = 0; k2 < 2; ++k2) a = mfma16(*(const LAS bf16x8*)(Tm + (16 * mt + fr) * 72 + 32 * k2 + 8 * fq), *(const LAS bf16x8*)(VBT + (16 * wave + fr) * 72 + 32 * k2 + 8 * fq), a);
        u32x2 w; w.x = pk2(a[0], a[1]); w.y = pk2(a[2], a[3]);
        *(u32x2*)(uT + ((wave * 4 + mt) * 64 + lane) * 4) = w;
    }
#pragma unroll
    for (int nt = 0; nt < 4; ++nt) {
        f32x4 a = {0.f, 0.f, 0.f, 0.f};
#pragma unroll
        for (int k2 = 0; k2 < 2; ++k2) a = mfma16(*(const LAS bf16x8*)(KBT + (16 * wave + fr) * 72 + 32 * k2 + 8 * fq), *(const LAS bf16x8*)(Tm + (16 * nt + fr) * 72 + 32 * k2 + 8 * fq), a);
        u32x2 w; w.x = pk2(a[0], a[1]); w.y = pk2(a[2], a[3]);
        *(u32x2*)(wF + fo_off(16 * nt + fr, 16 * wave + 4 * fq, 4)) = w;
    }
    __syncthreads();
}

__device__ __forceinline__ void e2_hgrn(const Params& p, LAS unsigned char* lds, int item) {
    int tid_ = threadIdx.x; asm volatile("" : "+v"(tid_));
    { unsigned lb_ = (unsigned)(size_t)lds; asm volatile("" : "+v"(lb_)); lds = (LAS unsigned char*)(size_t)lb_; }
    const int tid = tid_, lane = tid & 63, wave = tid >> 6, fr = lane & 15, fq = lane >> 4;
    const int seq = item >> 5, n = item & 31, b = seq >> 2, h = seq & 3;
    const int t = tid >> 3, sub = tid & 7, c0 = sub * 16;
    const size_t r = (size_t)b * TP + n * 64 + t;
    LAS float* Bf = (LAS float*)lds; LAS bf16_t* Qm = (LAS bf16_t*)(lds + 33792); LAS bf16_t* Km = (LAS bf16_t*)(lds + 51200);
    const bf16_t* P16 = (const bf16_t*)(p.ws + WS_P16); const float* LOGG = (const float*)(p.ws + WS_LOGG);
    unsigned char* blk = p.ws + WS_E2H + (size_t)item * E2H_BYTES;
    bf16_t* qF = (bf16_t*)blk; bf16_t* kF = (bf16_t*)(blk + 16384); bf16_t* vF = (bf16_t*)(blk + 32768); bf16_t* aF = (bf16_t*)(blk + 49152); float* ebl = (float*)(blk + 57344);
    {
        const float* lp = LOGG + r * 512 + h * 128 + c0;
#pragma unroll
        for (int i = 0; i < 4; ++i) *(LAS f32x4*)(Bf + t * 132 + c0 + 4 * i) = *(const f32x4*)(lp + 4 * i);
    }
    __syncthreads();
    if (tid < 128) { float run = 0.f; for (int i = 0; i < 64; ++i) { run += Bf[i * 132 + tid]; Bf[i * 132 + tid] = run; } }
    __syncthreads();
    {
        float q[16], k[16]; const bf16_t* pr = P16 + r * 4096 + h * 128 + c0;
        unpack8(*(const u32x4*)pr, q); unpack8(*(const u32x4*)(pr + 8), q + 8);
        unpack8(*(const u32x4*)(pr + 512), k); unpack8(*(const u32x4*)(pr + 520), k + 8);
        const u32x4 v0 = *(const u32x4*)(pr + 1024), v1 = *(const u32x4*)(pr + 1032);
        const unsigned vw[8] = {v0.x, v0.y, v0.z, v0.w, v1.x, v1.y, v1.z, v1.w};
        float tq[16], tqm[16], tkm[16];
#pragma unroll
        for (int i = 0; i < 16; ++i) {
            const float bt = Bf[t * 132 + c0 + i], bl = Bf[63 * 132 + c0 + i], bm = Bf[31 * 132 + c0 + i];
            tq[i] = q[i] * __expf(bt); tqm[i] = q[i] * __expf(bt - bm); tkm[i] = k[i] * __expf(bm - bt);
            kF[fo_off(c0 + i, t, 2)] = f2bf(k[i] * __expf(bl - bt));
            vF[fo_off(c0 + i, t, 2)] = (bf16_t)((i & 1) ? (vw[i >> 1] >> 16) : (vw[i >> 1] & 0xffffu));
            if (t == 0) ebl[c0 + i] = __expf(bl);
        }
        *(u32x4*)(qF + fo_off(t, c0, 4)) = pack8(tq); *(u32x4*)(qF + fo_off(t, c0 + 8, 4)) = pack8(tq + 8);
        *(LAS u32x4*)(Qm + t * 136 + c0) = pack8(tqm); *(LAS u32x4*)(Qm + t * 136 + c0 + 8) = pack8(tqm + 8);
        *(LAS u32x4*)(Km + t * 136 + c0) = pack8(tkm); *(LAS u32x4*)(Km + t * 136 + c0 + 8) = pack8(tkm + 8);
    }
    __syncthreads();
#pragma unroll
    for (int q2 = 0; q2 < 2; ++q2) {
        const int id = 2 * wave + q2, mt = id >> 2, nt = id & 3;
        f32x4 a = {0.f, 0.f, 0.f, 0.f};
#pragma unroll
        for (int ks4 = 0; ks4 < 4; ++ks4) a = mfma16(*(const LAS bf16x8*)(Km + (16 * mt + fr) * 136 + 32 * ks4 + 8 * fq), *(const LAS bf16x8*)(Qm + (16 * nt + fr) * 136 + 32 * ks4 + 8 * fq), a);
        const int tt = 16 * nt + fr; float o[4];
#pragma unroll
        for (int j = 0; j < 4; ++j) { const int s = 16 * mt + 4 * fq + j; o[j] = (s <= tt) ? a[j] : 0.f; }
        u32x2 w; w.x = pk2(o[0], o[1]); w.y = pk2(o[2], o[3]);
        *(u32x2*)(aF + fo_off(tt, 16 * mt + 4 * fq, 2)) = w;
    }
    __syncthreads();
}

template <bool GDN>
__device__ __forceinline__ void e3_prompt(const Params& p, LAS unsigned char* lds, int e, int seq) {
    int tid_ = threadIdx.x; asm volatile("" : "+v"(tid_));
    { unsigned lb_ = (unsigned)(size_t)lds; asm volatile("" : "+v"(lb_)); lds = (LAS unsigned char*)(size_t)lb_; }
    const int tid = tid_, lane = tid & 63, wave = tid >> 6, fr = lane & 15, fq = lane >> 4;
    const int b = seq >> 2, h = seq & 3, v0 = wave * 16;
    LAS bf16_t* SLw = (LAS bf16_t*)(lds) + wave * (16 * 136); LAS bf16_t* VTw = (LAS bf16_t*)(lds + 34816) + wave * (16 * 72);
    LAS float* OT = (LAS float*)(lds + 53248);
    LAS float* EBw = (LAS float*)(lds + 120832) + wave * 128;
    const bf16_t* P16 = (const bf16_t*)(p.ws + WS_P16); bf16_t* OA = (bf16_t*)(p.ws + WS_OA);
    const float* nw = (GDN ? p.in[12] : p.in[8]) + e * 128;
    constexpr size_t IB = GDN ? E2G_BYTES : E2H_BYTES;
    constexpr int QF = GDN ? 32768 : 0, AF = GDN ? 65536 : 49152, KF = GDN ? 49152 : 16384;
    const unsigned char* base = p.ws + (GDN ? WS_E2G : WS_E2H) + (size_t)seq * 32 * IB;
    const int t = tid >> 3, sub = tid & 7, c0 = sub * 16;
    f32x4 S[8];
#pragma unroll
    for (int kt = 0; kt < 8; ++kt) S[kt] = (f32x4){0.f, 0.f, 0.f, 0.f};
    for (int n = 0; n < 32; ++n) {
        const unsigned char* blk = base + (size_t)n * IB;
        unsigned pf0 = 0u, pf1 = 0u;
        if (n + 1 < 32) { pf0 = *(const unsigned*)(blk + IB + (size_t)tid * 128); if ((size_t)65536 + (size_t)tid * 128 < IB) pf1 = *(const unsigned*)(blk + IB + 65536 + (size_t)tid * 128); }
        bf16x8 bS[4], bV[2], qA[16], aA[8], kA[16];
        LAS float* OTc = OT + (n & 1) * (64 * 132);
        if (GDN) {
            bf16x8 wA[16]; u32x2 uu[4];
#pragma unroll
            for (int i = 0; i < 16; ++i) wA[i] = *(const bf16x8*)((const bf16_t*)(blk + 16384) + (i * 64 + lane) * 8);
#pragma unroll
            for (int mt = 0; mt < 4; ++mt) uu[mt] = *(const u32x2*)((const bf16_t*)blk + ((wave * 4 + mt) * 64 + lane) * 4);
#pragma unroll
            for (int i = 0; i < 16; ++i) qA[i] = *(const bf16x8*)((const bf16_t*)(blk + QF) + (i * 64 + lane) * 8);
#pragma unroll
            for (int kt = 0; kt < 8; ++kt) { u32x2 w2; w2.x = pk2(S[kt].x, S[kt].y); w2.y = pk2(S[kt].z, S[kt].w); *(LAS u32x2*)(SLw + fr * 136 + 16 * kt + 4 * fq) = w2; }
#pragma unroll
            for (int ks = 0; ks < 4; ++ks) bS[ks] = *(const LAS bf16x8*)(SLw + fr * 136 + 32 * ks + 8 * fq);
            __builtin_amdgcn_sched_barrier(0);
#pragma unroll
            for (int mt = 0; mt < 4; ++mt) {
                f32x4 pa = {0.f, 0.f, 0.f, 0.f};
#pragma unroll
                for (int ks = 0; ks < 4; ++ks) pa = mfma16(wA[mt * 4 + ks], bS[ks], pa);
                u32x2 w2; w2.x = pk2(bflo(uu[mt].x) - pa.x, bfhi(uu[mt].x) - pa.y); w2.y = pk2(bflo(uu[mt].y) - pa.z, bfhi(uu[mt].y) - pa.w);
                *(LAS u32x2*)(VTw + fr * 72 + 16 * mt + 4 * fq) = w2;
            }
#pragma unroll
            for (int i = 0; i < 8; ++i) aA[i] = *(const bf16x8*)((const bf16_t*)(blk + AF) + (i * 64 + lane) * 8);
            const float d = *(const float*)(blk + 73728);
#pragma unroll
            for (int k2 = 0; k2 < 2; ++k2) bV[k2] = *(const LAS bf16x8*)(VTw + fr * 72 + 32 * k2 + 8 * fq);
            __builtin_amdgcn_sched_barrier(0);
            f32x4 acc[4];
#pragma unroll
            for (int mt = 0; mt < 4; ++mt) {
                acc[mt] = (f32x4){0.f, 0.f, 0.f, 0.f};
#pragma unroll
                for (int ks = 0; ks < 4; ++ks) acc[mt] = mfma16(qA[mt * 4 + ks], bS[ks], acc[mt]);
            }
#pragma unroll
            for (int i = 0; i < 16; ++i) kA[i] = *(const bf16x8*)((const bf16_t*)(blk + KF) + (i * 64 + lane) * 8);
            __builtin_amdgcn_sched_barrier(0);
#pragma unroll
            for (int mt = 0; mt < 4; ++mt) {
#pragma unroll
                for (int k2 = 0; k2 < 2; ++k2) acc[mt] = mfma16(aA[mt * 2 + k2], bV[k2], acc[mt]);
#pragma unroll
                for (int j = 0; j < 4; ++j) OTc[(16 * mt + 4 * fq + j) * 132 + v0 + fr] = acc[mt][j];
            }
#pragma unroll
            for (int kt = 0; kt < 8; ++kt) {
                S[kt] = S[kt] * d;
#pragma unroll
                for (int k2 = 0; k2 < 2; ++k2) S[kt] = mfma16(kA[kt * 2 + k2], bV[k2], S[kt]);
            }
        } else {
#pragma unroll
            for (int i = 0; i < 16; ++i) qA[i] = *(const bf16x8*)((const bf16_t*)(blk + QF) + (i * 64 + lane) * 8);
#pragma unroll
            for (int i = 0; i < 8; ++i) aA[i] = *(const bf16x8*)((const bf16_t*)(blk + AF) + (i * 64 + lane) * 8);
#pragma unroll
            for (int k2 = 0; k2 < 2; ++k2) bV[k2] = *(const bf16x8*)((const bf16_t*)(blk + 32768) + ((wave * 2 + k2) * 64 + lane) * 8);
            const f32x4 ev = *(const f32x4*)((const float*)(blk + 57344) + 4 * (lane & 31));
#pragma unroll
            for (int kt = 0; kt < 8; ++kt) { u32x2 w2; w2.x = pk2(S[kt].x, S[kt].y); w2.y = pk2(S[kt].z, S[kt].w); *(LAS u32x2*)(SLw + fr * 136 + 16 * kt + 4 * fq) = w2; }
#pragma unroll
            for (int ks = 0; ks < 4; ++ks) bS[ks] = *(const LAS bf16x8*)(SLw + fr * 136 + 32 * ks + 8 * fq);
            __builtin_amdgcn_sched_barrier(0);
            f32x4 acc[4];
#pragma unroll
            for (int mt = 0; mt < 4; ++mt) {
                acc[mt] = (f32x4){0.f, 0.f, 0.f, 0.f};
#pragma unroll
                for (int ks = 0; ks < 4; ++ks) acc[mt] = mfma16(qA[mt * 4 + ks], bS[ks], acc[mt]);
            }
#pragma unroll
            for (int i = 0; i < 16; ++i) kA[i] = *(const bf16x8*)((const bf16_t*)(blk + KF) + (i * 64 + lane) * 8);
            if (lane < 32) *(LAS f32x4*)(EBw + 4 * lane) = ev;
            __builtin_amdgcn_sched_barrier(0);
#pragma unroll
            for (int mt = 0; mt < 4; ++mt) {
#pragma unroll
                for (int k2 = 0; k2 < 2; ++k2) acc[mt] = mfma16(aA[mt * 2 + k2], bV[k2], acc[mt]);
#pragma unroll
                for (int j = 0; j < 4; ++j) OTc[(16 * mt + 4 * fq + j) * 132 + v0 + fr] = acc[mt][j];
            }
#pragma unroll
            for (int kt = 0; kt < 8; ++kt) {
                S[kt] = S[kt] * *(const LAS f32x4*)(EBw + 16 * kt + 4 * fq);
#pragma unroll
                for (int k2 = 0; k2 < 2; ++k2) S[kt] = mfma16(kA[kt * 2 + k2], bV[k2], S[kt]);
            }
        }
        asm volatile("" :: "v"(pf0), "v"(pf1));
        __syncthreads();
        {
            const size_t r = (size_t)b * TP + n * 64 + t;
            const bf16_t* gp = P16 + r * 4096 + (GDN ? 3584 : 1536) + h * 128 + c0;
            const u32x4 g0 = *(const u32x4*)gp, g1 = *(const u32x4*)(gp + 8);
            float o[16]; float sq = 0.f;
#pragma unroll
            for (int i = 0; i < 4; ++i) { const f32x4 v = *(const LAS f32x4*)(OTc + t * 132 + c0 + 4 * i); o[4 * i] = v.x; o[4 * i + 1] = v.y; o[4 * i + 2] = v.z; o[4 * i + 3] = v.w; sq += (v.x * v.x + v.y * v.y) + (v.z * v.z + v.w * v.w); }
            sq += __shfl_xor(sq, 1); sq += __shfl_xor(sq, 2); sq += __shfl_xor(sq, 4);
            const float rstd = rsqrtf(sq * (1.f / 128.f) + EPS);
            float gt[16]; unpack8(g0, gt); unpack8(g1, gt + 8);
#pragma unroll
            for (int i = 0; i < 16; ++i) { const float gate = GDN ? silu(gt[i]) : sigm(gt[i]); o[i] = o[i] * rstd * nw[c0 + i] * gate; }
            bf16_t* op = OA + r * D + (GDN ? 512 : 0) + h * 128 + c0;
            *(u32x4*)op = pack8(o); *(u32x4*)(op + 8) = pack8(o + 8);
        }
    }
    float* so = p.out + (GDN ? O_GDP : O_HGP) + ((size_t)(e * NB + b) * 4 + h) * 16384;
#pragma unroll
    for (int kt = 0; kt < 8; ++kt)
#pragma unroll
        for (int j = 0; j < 4; ++j) so[(16 * kt + 4 * fq + j) * 128 + v0 + fr] = S[kt][j];
    __syncthreads();
}

__device__ __forceinline__ void e3_sample(const Params& p, LAS unsigned char* lds, int e, int mx, int bh) {
    int tid_ = threadIdx.x; asm volatile("" : "+v"(tid_));
    { unsigned lb_ = (unsigned)(size_t)lds; asm volatile("" : "+v"(lb_)); lds = (LAS unsigned char*)(size_t)lb_; }
    const int tid = tid_, lane = tid & 63, wave = tid >> 6;
    const int b = bh >> 2, h = bh & 3; const size_t r = (size_t)MP + b;
    const bool gdn = (mx == 1);
    LAS float* qs = (LAS float*)lds; LAS float* ks = qs + 128; LAS float* gs = qs + 256; LAS float* vs = qs + 384; LAS float* vn = qs + 512; LAS float* misc = qs + 640; LAS float* red = qs + 1024;
    const bf16_t* P16 = (const bf16_t*)(p.ws + WS_P16); bf16_t* OA = (bf16_t*)(p.ws + WS_OA);
    float eg = 1.f, beta = 0.f;
    if (tid < 128) {
        const int c = tid;
        if (!gdn) {
            const bf16_t* pr = P16 + r * 4096 + h * 128 + c;
            qs[c] = bf2f(pr[0]); ks[c] = bf2f(pr[512]); vs[c] = bf2f(pr[1024]);
            gs[c] = __expf(((const float*)(p.ws + WS_LOGG))[r * 512 + h * 128 + c]);
        } else {
            const float* cw = p.in[9] + (size_t)e * 4 * 1536; const float* cb = p.in[4] + (size_t)(e * MS + b) * 3 * 1536;
            float* cso = p.out + O_CVS + (size_t)(e * MS + b) * 3 * 1536; float val[3];
#pragma unroll
            for (int part = 0; part < 3; ++part) {
                const int ch = part * 512 + h * 128 + c; const float x3 = bf2f(P16[r * 4096 + 2048 + ch]);
                const float b0 = cb[ch], b1 = cb[1536 + ch], b2 = cb[3072 + ch];
                val[part] = silu(b0 * cw[ch] + b1 * cw[1536 + ch] + b2 * cw[3072 + ch] + x3 * cw[4608 + ch]);
                cso[ch] = b1; cso[1536 + ch] = b2; cso[3072 + ch] = x3;
            }
            float q2 = wave_sum(val[0] * val[0]), k2 = wave_sum(val[1] * val[1]);
            if (lane == 0) { misc[wave] = q2; misc[2 + wave] = k2; }
            qs[c] = val[0]; ks[c] = val[1]; vs[c] = val[2];
        }
    }
    __syncthreads();
    if (gdn) {
        const float qn = rsqrtf(misc[0] + misc[1] + EPS) * 0.08838834764831845f, kn = rsqrtf(misc[2] + misc[3] + EPS);
        const float* AB = (const float*)(p.ws + WS_AB);
        const float a = AB[r * 8 + h], bb = AB[r * 8 + 4 + h];
        const float Ah = __expf(p.in[10][e * 4 + h]); const float x = a + p.in[11][e * 4 + h];
        const float sp = x > 20.f ? x : log1pf(__expf(x));
        eg = __expf(-Ah * sp); beta = sigm(bb);
        __syncthreads();
        if (tid < 128) { qs[tid] *= qn; ks[tid] *= kn; }
        __syncthreads();
    }
    const int c4 = (tid & 31) * 4, rg = tid >> 5;
    const float* s0 = (gdn ? p.in[3] : p.in[2]) + ((size_t)(e * MS + b) * 4 + h) * 16384;
    float* so = p.out + (gdn ? O_GDS : O_HGS) + ((size_t)(e * MS + b) * 4 + h) * 16384;
    f32x4 Sv[8];
#pragma unroll
    for (int i = 0; i < 8; ++i) Sv[i] = *(const f32x4*)(s0 + (rg + 16 * i) * 128 + c4);
    f32x4 vv;
    if (gdn) {
        f32x4 pk = {0.f, 0.f, 0.f, 0.f};
#pragma unroll
        for (int i = 0; i < 8; ++i) pk = pk + Sv[i] * ks[rg + 16 * i];
        *(LAS f32x4*)(red + rg * 128 + c4) = pk;
        __syncthreads();
        if (tid < 128) { float s = 0.f;
#pragma unroll
            for (int i = 0; i < 16; ++i) s += red[i * 128 + tid];
            vn[tid] = beta * vs[tid] - beta * eg * s; }
        __syncthreads();
        vv = *(const LAS f32x4*)(vn + c4);
    } else vv = *(const LAS f32x4*)(vs + c4);
    f32x4 po = {0.f, 0.f, 0.f, 0.f};
#pragma unroll
    for (int i = 0; i < 8; ++i) {
        const int k = rg + 16 * i; const float dk = gdn ? eg : gs[k];
        const f32x4 sn = Sv[i] * dk + vv * ks[k];
        *(f32x4*)(so + k * 128 + c4) = sn;
        po = po + sn * qs[k];
    }
    __syncthreads();
    *(LAS f32x4*)(red + rg * 128 + c4) = po;
    __syncthreads();
    float o = 0.f;
    if (tid < 128) {
#pragma unroll
        for (int i = 0; i < 16; ++i) o += red[i * 128 + tid];
        const float s2 = wave_sum(o * o); if (lane == 0) misc[4 + wave] = s2;
    }
    __syncthreads();
    if (tid < 128) {
        const float rstd = rsqrtf((misc[4] + misc[5]) * (1.f / 128.f) + EPS);
        const float gr = bf2f(P16[r * 4096 + (gdn ? 3584 : 1536) + h * 128 + tid]);
        const float gate = gdn ? silu(gr) : sigm(gr);
        const float nwv = (gdn ? p.in[12] : p.in[8])[e * 128 + tid];
        OA[r * D + (gdn ? 512 : 0) + h * 128 + tid] = f2bf(o * rstd * nwv * gate);
    }
    __syncthreads();
}

__device__ __forceinline__ void phase_pool(const Params& p, int o) {
    const bf16_t* U = (const bf16_t*)(p.ws + WS_P16); bf16_t* Dp = (bf16_t*)(p.ws + WS_P16 + (size_t)M * 1024 * 2);
    int tid_ = threadIdx.x; asm volatile("" : "+v"(tid_));
    const int gt = blockIdx.x * 512 + tid_, NGT = gridDim.x * 512;
    for (int idx = gt; idx < MR * 128; idx += NGT) {
        const int r = idx >> 7, c = (idx & 127) * 8, w = 2 << (c >> 8);
        float u[8], s[8]; unpack8(*(const u32x4*)(U + (size_t)r * D + c), u);
#pragma unroll
        for (int i = 0; i < 8; ++i) s[i] = u[i];
        float cnt;
        if (r < MP) {
            const int t = r & (TP - 1), b = r >> 11; cnt = (float)((t + 1 < w) ? t + 1 : w);
            const int lim = (w - 1 < t) ? w - 1 : t;
            u32x4 xr[15];
#pragma unroll
            for (int i = 1; i < 16; ++i) xr[i - 1] = *(const u32x4*)(U + (size_t)(r - ((i <= lim) ? i : 0)) * D + c);
#pragma unroll
            for (int i = 1; i < 16; ++i) { float x[8]; unpack8(xr[i - 1], x); const float m = (i <= lim) ? 1.f : 0.f;
#pragma unroll
                for (int q = 0; q < 8; ++q) s[q] += m * x[q]; }
            if (t >= TP - 15) { float* op = p.out + O_PLP + ((size_t)(o * NB + b) * 15 + (t - (TP - 15))) * D + c;
                *(f32x4*)op = (f32x4){u[0], u[1], u[2], u[3]}; *(f32x4*)(op + 4) = (f32x4){u[4], u[5], u[6], u[7]}; }
        } else {
            const int b = r - MP; cnt = (float)w;
            const float* buf = p.in[5] + (size_t)(o * MS + b) * 15 * D + c;
#pragma unroll
            for (int i = 1; i < 16; ++i) { if (i < w) { const f32x4 x0 = *(const f32x4*)(buf + (15 - i) * D), x1 = *(const f32x4*)(buf + (15 - i) * D + 4);
                s[0] += x0.x; s[1] += x0.y; s[2] += x0.z; s[3] += x0.w; s[4] += x1.x; s[5] += x1.y; s[6] += x1.z; s[7] += x1.w; } }
            float* op = p.out + O_PLS + (size_t)(o * MS + b) * 15 * D + c;
#pragma unroll
            for (int j = 0; j < 14; ++j) { *(f32x4*)(op + j * D) = *(const f32x4*)(buf + (j + 1) * D); *(f32x4*)(op + j * D + 4) = *(const f32x4*)(buf + (j + 1) * D + 4); }
            *(f32x4*)(op + 14 * D) = (f32x4){u[0], u[1], u[2], u[3]}; *(f32x4*)(op + 14 * D + 4) = (f32x4){u[4], u[5], u[6], u[7]};
        }
        const float ic = 1.f / cnt; float d[8];
#pragma unroll
        for (int i = 0; i < 8; ++i) d[i] = s[i] * ic - u[i];
        *(u32x4*)(Dp + (size_t)r * D + c) = pack8(d);
    }
}

__device__ __forceinline__ void phase_final(const Params& p) {
    int tid_ = threadIdx.x; asm volatile("" : "+v"(tid_));
    const int tid = tid_, lane = tid & 63, wave = tid >> 6;
    const int gw = blockIdx.x * 8 + wave, NGW = gridDim.x * 8;
    const u64* ss = (const u64*)(p.ws + WS_SS) + (size_t)12 * M; const float* fw = p.in[26];
    f32x4 wv[4];
#pragma unroll
    for (int j = 0; j < 4; ++j) wv[j] = *(const f32x4*)(fw + 4 * lane + 256 * j);
    for (int r = gw; r < MR; r += 2 * NGW) {
        const int r2 = r + NGW; const bool has2 = r2 < MR; const int rb = has2 ? r2 : r;
        const u64 s1 = ss[r], s2 = ss[rb];
        float* xp = p.out + (size_t)r * D; float* xq = p.out + (size_t)rb * D;
        f32x4 a[4], b[4];
#pragma unroll
        for (int j = 0; j < 4; ++j) { const int c = 4 * lane + 256 * j; a[j] = *(const f32x4*)(xp + c); b[j] = *(const f32x4*)(xq + c); }
        const float rs1 = SS_RS(s1), rs2 = SS_RS(s2);
#pragma unroll
        for (int j = 0; j < 4; ++j) { const int c = 4 * lane + 256 * j; *(f32x4*)(xp + c) = a[j] * wv[j] * rs1; }
        if (has2) {
#pragma unroll
            for (int j = 0; j < 4; ++j) { const int c = 4 * lane + 256 * j; *(f32x4*)(xq + c) = b[j] * wv[j] * rs2; }
        }
    }
}

#define XB_TMO      128
#define XB_XCNT(j)  (256  + 64 * (j))
#define XB_XSUB(j)  (1280 + 64 * (j))
#define XB_XGEN(j)  (2304 + 64 * (j))
#define XB_TOP      3328
#define XB_TOPGEN   3392
#define XCD_BAR_WORDS 3456
#define TS_OFF (WS_END + 16384)
#define XB_SPIN_CAP (1u << 22)
__device__ __forceinline__ unsigned xb_ld(unsigned* p) { return __hip_atomic_load(p, __ATOMIC_RELAXED, __HIP_MEMORY_SCOPE_AGENT); }
__device__ __forceinline__ unsigned xb_add(unsigned* p, unsigned v) { return __hip_atomic_fetch_add(p, v, __ATOMIC_RELAXED, __HIP_MEMORY_SCOPE_AGENT); }
__device__ __forceinline__ unsigned xb_xcc_id() { return (unsigned)__builtin_amdgcn_s_getreg((3 << 11) | 20) & 0xFu; }
#define XB_SPIN(cond, bar) do { unsigned _sp = 0; while (cond) { __builtin_amdgcn_s_sleep(1); \
    if ((++_sp & 255u) == 0u) { if (xb_ld(&(bar)[XB_TMO])) break; if (_sp > XB_SPIN_CAP) { atomicAdd(&(bar)[XB_TMO], 1u); break; } } } } while (0)
struct XcdBarrier { unsigned* bar; unsigned x; volatile LAS unsigned* st; };
__device__ __forceinline__ XcdBarrier xcd_barrier_post(unsigned* bar, volatile LAS unsigned* st) {
    XcdBarrier b; b.bar = bar; b.x = xb_xcc_id(); b.st = st;
    if (threadIdx.x == 0) (void)xb_add(&bar[XB_XCNT(b.x)], 1u);
    return b;
}
__device__ __forceinline__ void xcd_barrier_complete(unsigned* bar, unsigned x, unsigned& nloc, unsigned& nx) {
    const unsigned G = gridDim.x * gridDim.y * gridDim.z;
    unsigned sum, cnt, mine, sp = 0u;
    for (;;) {
        sum = 0u; cnt = 0u; mine = 0u;
#pragma unroll
        for (unsigned j = 0; j < 16; ++j) { const unsigned c = xb_ld(&bar[XB_XCNT(j)]); sum += c; cnt += (c > 0u) ? 1u : 0u; mine = (j == x) ? c : mine; }
        if (sum == G) break;
        __builtin_amdgcn_s_sleep(1);
        if ((++sp & 255u) == 0u) { if (xb_ld(&bar[XB_TMO])) break; if (sp > XB_SPIN_CAP) { atomicAdd(&bar[XB_TMO], 1u); break; } }
    }
    nloc = mine > 0u ? mine : 1u; nx = cnt > 0u ? cnt : 1u;
}
__device__ __forceinline__ void xcd_barrier(const XcdBarrier& b) {
    asm volatile("s_waitcnt vmcnt(0)" ::: "memory");
    __syncthreads();
    if (threadIdx.x == 0) {
        unsigned* bar = b.bar;
        __builtin_amdgcn_s_waitcnt(0);
        unsigned nloc = b.st[0], nx = b.st[1];
        if (nloc == 0u) { xcd_barrier_complete(bar, b.x, nloc, nx); b.st[0] = nloc; b.st[1] = nx; }
        const unsigned old = xb_add(&bar[XB_XSUB(b.x)], 1u);
        const unsigned gen = old / nloc;
        if (old + 1u == (gen + 1u) * nloc) {
            __builtin_amdgcn_fence(__ATOMIC_RELEASE, "agent");
            asm volatile("s_waitcnt vmcnt(0)" ::: "memory");
            const unsigned og = xb_add(&bar[XB_TOP], 1u);
            const unsigned tg = og / nx;
            if (og + 1u == (tg + 1u) * nx) xb_add(&bar[XB_TOPGEN], 1u);
            else XB_SPIN(xb_ld(&bar[XB_TOPGEN]) == tg, bar);
            __builtin_amdgcn_fence(__ATOMIC_ACQUIRE, "agent");
            xb_add(&bar[XB_XGEN(b.x)], 1u);
            asm volatile("s_waitcnt vmcnt(0)" ::: "memory");
        } else {
            XB_SPIN(xb_ld(&bar[XB_XGEN(b.x)]) == gen, bar);
            __builtin_amdgcn_fence(__ATOMIC_ACQUIRE, "agent");
            asm volatile("s_waitcnt vmcnt(0)" ::: "memory");
        }
    }
    __syncthreads();
}

__global__ void __launch_bounds__(512) mega(Params p) {
    extern __shared__ __attribute__((aligned(16))) unsigned char shm[];
    LAS unsigned char* lds = (LAS unsigned char*)shm;
    cg::grid_group grid = cg::this_grid();
    unsigned char* ws = p.ws;
    volatile LAS unsigned* xst = (volatile LAS unsigned*)(lds + 131072);
    if (threadIdx.x == 0) { xst[0] = 0u; xst[1] = 0u; }
    __syncthreads();
    XcdBarrier xb = xcd_barrier_post((unsigned*)(ws + WS_END), xst);
    const int G = gridDim.x;
    u64* SS = (u64*)(ws + WS_SS);
    bf16_t* XB = (bf16_t*)(ws + WS_XB);
    __builtin_amdgcn_fence(__ATOMIC_ACQUIRE, "agent");
    for (int ph = p.ph_lo; ph < p.ph_hi; ++ph) {
        int kind, li = 0, half = 0;
        if (ph == 0) kind = 0;
        else if (ph == NPH - 1) kind = 10;
        else {
            int q = ph - 1;
            if (q < 8) li = 0; else if (q < 15) { li = 1; q -= 8; } else if (q < 23) { li = 2; q -= 15; } else { li = 3; q -= 23; }
            const bool even = !(li & 1);
            if (q == 0) { kind = 1; half = 0; } else if (q == 1) { kind = 2; half = 0; }
            else if (even) { if (q < 6) kind = q + 1; else { kind = q - 5; half = 1; } }
            else { if (q < 5) kind = q + 5; else { kind = q - 4; half = 1; } }
        }
        const int e = li >> 1, f = li * 2 + half;
        pg8::StaticOrder S;
        if (kind == 0) phase_prep(p, lds);
        else if (kind == 1) {
            pg8::Gemm g{XB, (const bf16_t*)(ws + WS_WGU + f * SZ_WGU), NMT, 22, 1024, 1024, 0, 1024, 22, 0};
            unsigned* cnt = (unsigned*)(ws + WS_END + 16384) + 31 * 128 + f;
            pg8::EpiGU E{(bf16_t*)(ws + WS_P16), SS + (size_t)(3 * li + (half ? 2 : 0)) * M, (G == 256) ? cnt : nullptr};
            if (G == 256) S.init_f1(blockIdx.x); else S.init(g.nM, g.nN, G, blockIdx.x);
            pg8::gemm_phase(lds, g, S, E);
            if (G == 256 && blockIdx.x >= 248) {
                if (threadIdx.x == 0) { unsigned sp = 0; while (xb_ld(cnt) < 22u * 8u) { __builtin_amdgcn_s_sleep(2); if (++sp > (1u << 24)) break; } }
                __syncthreads();
                __builtin_amdgcn_fence(__ATOMIC_ACQUIRE, "agent");
                asm volatile("s_waitcnt vmcnt(0)" ::: "memory");
                pg8::EpiX EX; EX.X = p.out; EX.XB = XB; EX.scale = nullptr; EX.alpha = 0.5f; EX.ssn = SS + (size_t)(3 * li + (half ? 3 : 1)) * M;
                pg8::Gemm gs{(const bf16_t*)(ws + WS_P16), (const bf16_t*)(ws + WS_WD + f * SZ_WD), 1, 8, 1408, 2816, 0, 2816, 4, 64};
                pg8::EpiSplitX ES{EX, (float*)(ws + WS_E2G), (unsigned*)(ws + WS_END + 16384) + ph * 128, 4};
                S.init(1, 8, 8, blockIdx.x - 248); pg8::gemm_phase(lds, gs, S, ES);
            }
        } else if ((kind == 2 || kind == 6 || kind == 9)) {
            pg8::Gemm g; pg8::EpiX E; E.X = p.out; E.XB = XB; E.scale = nullptr;
            int NS = 0;
            if (kind == 2) { g = pg8::Gemm{(const bf16_t*)(ws + WS_P16), (const bf16_t*)(ws + WS_WD + f * SZ_WD), 64, 4, 2816, 2816, 0, 2816, 4, 0}; E.alpha = 0.5f; E.ssn = SS + (size_t)(3 * li + (half ? 3 : 1)) * M; NS = 2; }
            else if (kind == 6) { g = pg8::Gemm{(const bf16_t*)(ws + WS_OA), (const bf16_t*)(ws + WS_WOUT + e * SZ_W1K), NMT, 4, 1024, 1024, 0, 1024, 4, 0}; E.alpha = 1.f; E.ssn = SS + (size_t)(3 * li + 2) * M; }
            else { g = pg8::Gemm{(const bf16_t*)(ws + WS_P16 + (size_t)M * 1024 * 2), (const bf16_t*)(ws + WS_WGRP + e * SZ_WGRP), NMT, 4, 256, 1024, 256, 256, 4, 0}; E.alpha = 1.f; E.ssn = SS + (size_t)(3 * li + 2) * M; E.scale = p.in[16] + e * D; }
            S.init(g.nM, g.nN, G, blockIdx.x); pg8::gemm_phase(lds, g, S, E);
            if (NS && G != 256) {
                pg8::Gemm gs = g; gs.nM = 1; gs.nN = 4 * NS; gs.K = g.K / NS; gs.pm0 = 64;
                pg8::EpiSplitX ES{E, (float*)(ws + WS_E2G), (unsigned*)(ws + WS_END + 16384) + ph * 128, 4};
                S.init(gs.nM, gs.nN, G, blockIdx.x); pg8::gemm_phase(lds, gs, S, ES);
            }
        } else if (kind == 3) {
            const u64* ss = SS + (size_t)(3 * li + 1) * M;
            pg8::Gemm g{XB, (const bf16_t*)(ws + WS_WIN + e * SZ_WIN), NMT, 16, 1024, 1024, 0, 1024, 16, 0};
            pg8::EpiP E{(bf16_t*)(ws + WS_P16), (float*)(ws + WS_LOGG), ss, p.in[6], e};
            S.init(g.nM, g.nN, G, blockIdx.x); pg8::gemm_phase(lds, g, S, E);
            phase_ab(p, e, ss);
        } else if (kind == 4) {
            for (int it = blockIdx.x, k = 0; it < 2048; it += G, ++k) { if ((it + k) & 1) e2_gdn(p, lds, e, it >> 1); else e2_hgrn(p, lds, it >> 1); }
        } else if (kind == 5) {
            if (G > 64) {
                if (blockIdx.x < 64) { if (blockIdx.x & 1) e3_prompt<true>(p, lds, e, blockIdx.x >> 1); else e3_prompt<false>(p, lds, e, blockIdx.x >> 1); }
                else {
                    for (int s = blockIdx.x - 64; s < 1024; s += G - 64) e3_sample(p, lds, e, s & 1, s >> 1);
                    __syncthreads();
                    int tid2 = threadIdx.x; asm volatile("" : "+v"(tid2));
                    LAS float* scr = (LAS float*)(lds + (tid2 >> 6) * 8448);
                    const int worker = (blockIdx.x - 64) * 8 + (tid2 >> 6), nworkers = (G - 64) * 8;
                    if (li == 0) { convert_layer(p, scr, 1, worker, nworkers, tid2 & 63); convert_layer(p, scr, 2, worker, nworkers, tid2 & 63); }
                    else convert_layer(p, scr, 3, worker, nworkers, tid2 & 63);
                    __syncthreads();
                }
            } else {
                for (int it = blockIdx.x; it < 64; it += G) { if (it & 1) e3_prompt<true>(p, lds, e, it >> 1); else e3_prompt<false>(p, lds, e, it >> 1); }
                for (int s = blockIdx.x; s < 1024; s += G) e3_sample(p, lds, e, s & 1, s >> 1);
            }
        } else if (kind == 7) {
            pg8::Gemm g{XB, (const bf16_t*)(ws + WS_WP + e * SZ_W1K), NMT, 4, 1024, 1024, 0, 1024, 4, 0};
            pg8::EpiU E{(bf16_t*)(ws + WS_P16), SS + (size_t)(3 * li + 1) * M};
            S.init(g.nM, g.nN, G, blockIdx.x); pg8::gemm_phase(lds, g, S, E);
        } else if (kind == 8) phase_pool(p, e);
        else if (kind == 10) phase_final(p);
        if (ph + 1 < p.ph_hi) { if (p.ph_lo < 0) grid.sync(); else xcd_barrier(xb); }
    }
    __builtin_amdgcn_fence(__ATOMIC_RELEASE, "agent");
}

extern "C" void kernel_launch(void* const* d_in, const int* in_sizes, int n_in, void* d_out, int out_size, void* d_ws, size_t ws_size, hipStream_t stream) {
    static int grid = 0;
    if (grid == 0) {
        if (n_in != 27 || ws_size < WS_END + 32768) { fprintf(stderr, "kernel_launch: unexpected inputs (n_in %d, ws %zu, need %zu)\n", n_in, ws_size, (size_t)WS_END + 32768); grid = -1; return; }
        int dev = 0, cus = 0, per_cu = 0;
        (void)hipGetDevice(&dev); (void)hipDeviceGetAttribute(&cus, hipDeviceAttributeMultiprocessorCount, dev);
        (void)hipFuncSetAttribute((const void*)mega, hipFuncAttributeMaxDynamicSharedMemorySize, LDS_BYTES);
        (void)hipOccupancyMaxActiveBlocksPerMultiprocessor(&per_cu, (const void*)mega, 512, LDS_BYTES);
        (void)hipGetLastError();
        grid = cus;
    }
    if (grid < 0) return;
    Params p{};
    for (int i = 0; i < 27; ++i) p.in[i] = (const float*)d_in[i];
    p.out = (float*)d_out; p.ws = (unsigned char*)d_ws;
    (void)hipMemsetAsync((char*)d_ws + WS_END, 0, 32768, stream);
    p.ph_lo = 0; p.ph_hi = NPH;
    void* args[] = {&p};
    hipError_t e = hipLaunchCooperativeKernel((const void*)mega, dim3(grid), dim3(512), args, LDS_BYTES, stream);
    if (e != hipSuccess) fprintf(stderr, "cooperative launch failed: %s\n", hipGetErrorString(e));
}
```

```cpp
#include <hip/hip_runtime.h>
#include <hip/hip_cooperative_groups.h>
#include <cstdio>
namespace cg = cooperative_groups;


#define LAS __attribute__((address_space(3)))
typedef unsigned short bf16_t;
typedef short bf16x8 __attribute__((ext_vector_type(8)));
typedef float f32x4 __attribute__((ext_vector_type(4)));
typedef unsigned u32x4 __attribute__((ext_vector_type(4)));
typedef unsigned u32x2 __attribute__((ext_vector_type(2)));
typedef unsigned long long u64;
#define SS_RS(v) rsqrtf((float)(v) * (1.f / (16777216.f * 1024.f)) + EPS)

constexpr int D = 1024, FF = 2816, TP = 2048, NB = 8, MP = 16384, MS = 128, MR = 16512, M = 16640;
constexpr int NMT = M / 256;
constexpr float EPS = 1e-6f;
constexpr int NPH = 32;
constexpr int LDS_BYTES = 131072 + 16;

constexpr size_t SZ_WGU = (size_t)5632 * 1024 * 2, SZ_WD = (size_t)1024 * 2816 * 2, SZ_WIN = (size_t)4096 * 1024 * 2, SZ_W1K = (size_t)1024 * 1024 * 2, SZ_WGRP = (size_t)1024 * 256 * 2;
constexpr size_t WS_WGU = 0;
constexpr size_t WS_WD = WS_WGU + 8 * SZ_WGU;
constexpr size_t WS_WIN = WS_WD + 8 * SZ_WD;
constexpr size_t WS_WOUT = WS_WIN + 2 * SZ_WIN;
constexpr size_t WS_WP = WS_WOUT + 2 * SZ_W1K;
constexpr size_t WS_WGRP = WS_WP + 2 * SZ_W1K;
constexpr size_t WS_WAB = WS_WGRP + 2 * SZ_WGRP;
constexpr size_t WS_XB = WS_WAB + 2 * 8 * 1024 * 4;
constexpr size_t WS_SS = WS_XB + (size_t)M * 1024 * 2;
constexpr size_t WS_AB = WS_SS + (size_t)13 * M * 8;
constexpr size_t WS_OA = WS_AB + (size_t)M * 8 * 4;
constexpr size_t WS_LOGG = WS_OA + (size_t)M * 1024 * 2;
constexpr size_t WS_P16 = WS_LOGG + (size_t)M * 512 * 4;
constexpr size_t E2G_BYTES = 73984, E2H_BYTES = 57856;
constexpr size_t WS_E2G = WS_P16 + (size_t)M * 4096 * 2;
constexpr size_t WS_E2H = WS_E2G + 1024 * E2G_BYTES;
constexpr size_t WS_END = WS_E2H + 1024 * E2H_BYTES;

constexpr size_t O_Y = 0, O_HGP = 16908288, O_GDP = 17956864, O_CVP = 19005440, O_PLP = 19079168, O_HGS = 19324928, O_GDS = 36102144, O_CVS = 52879360, O_PLS = 54059008;

struct Params {
    const float* in[27];
    float* out;
    unsigned char* ws;
    int ph_lo, ph_hi;
};

typedef __bf16 bf16x2_t __attribute__((ext_vector_type(2)));
typedef float f32x2_t __attribute__((ext_vector_type(2)));
__device__ __forceinline__ unsigned pk2(float lo, float hi) { f32x2_t v = {lo, hi}; bf16x2_t b = __builtin_convertvector(v, bf16x2_t); return __builtin_bit_cast(unsigned, b); }
__device__ __forceinline__ bf16_t f2bf(float f) { return (bf16_t)(pk2(f, 0.f) & 0xffffu); }
__device__ __forceinline__ float bf2f(bf16_t b) { return __uint_as_float(((unsigned)b) << 16); }
__device__ __forceinline__ float bflo(unsigned w) { return __uint_as_float(w << 16); }
__device__ __forceinline__ float bfhi(unsigned w) { return __uint_as_float(w & 0xffff0000u); }
__device__ __forceinline__ float sigm(float x) { return __builtin_amdgcn_rcpf(1.f + __expf(-x)); }
__device__ __forceinline__ float silu(float x) { return x * sigm(x); }
__device__ __forceinline__ void unpack8(u32x4 a, float* x) { x[0] = bflo(a.x); x[1] = bfhi(a.x); x[2] = bflo(a.y); x[3] = bfhi(a.y); x[4] = bflo(a.z); x[5] = bfhi(a.z); x[6] = bflo(a.w); x[7] = bfhi(a.w); }
__device__ __forceinline__ u32x4 pack8(const float* x) { u32x4 r; r.x = pk2(x[0], x[1]); r.y = pk2(x[2], x[3]); r.z = pk2(x[4], x[5]); r.w = pk2(x[6], x[7]); return r; }
__device__ __forceinline__ float wave_sum(float v) {
#pragma unroll
    for (int o = 1; o < 64; o <<= 1) v += __shfl_xor(v, o);
    return v;
}
#define LDS_WAIT() asm volatile("s_waitcnt lgkmcnt(0)" ::: "memory")
__device__ __forceinline__ int fo_off(int R, int C, int KS) { return ((((R >> 4) * KS + (C >> 5)) * 64 + ((C >> 3) & 3) * 16 + (R & 15)) << 3) + (C & 7); }
__device__ __forceinline__ f32x4 mfma16(bf16x8 a, bf16x8 b, f32x4 c) { return __builtin_amdgcn_mfma_f32_16x16x32_bf16(a, b, c, 0, 0, 0); }

namespace pg8 {
constexpr int BM = 256, BK = 64, HALF = 128, HTB = HALF * BK * 2, NXCD = 8, WGM = 8;
__device__ __forceinline__ int lds_byte(int r, int c) { const int st = (r >> 4) * 2 + (c >> 5), rr = r & 15, cc = c & 31, ob = rr * 64 + cc * 2; return st * 1024 + (ob ^ (((ob >> 9) & 1) << 5)); }
__device__ __forceinline__ void stage_rc(int b, int& R, int& C) { const int st = b / 1024, sb = b % 1024, swz = sb ^ (((sb >> 9) & 1) << 5); R = (st >> 1) * 16 + swz / 64; C = (st & 1) * 32 + (swz % 64) / 2; }
__device__ __forceinline__ int perm32(int rho) { const int n = rho >> 4, i = rho & 15; return 8 * (i >> 2) + 4 * n + (i & 3); }
struct Unit { int pm, pn; };
struct Gemm { const bf16_t* A; const bf16_t* Bt; int nM, nN, K, lda, apn, ldb, nNr, pm0; };
struct StaticOrder {
    int nM, nN, nwg, G, c, mode;
    __device__ void init(int nM_, int nN_, int G_, int c_) { nM = nM_; nN = nN_; nwg = nM * nN; G = G_; c = c_; mode = 0; }
    __device__ void init_f1(int c_) { nM = 64; nN = 22; nwg = 1408; G = 256; c = c_; mode = 1; }
    __device__ bool next(int i, Unit& u) const {
        long L = (long)i * G + c;
        if (mode == 1) {
            if (c >= 248) { if (i >= 4) return false; }
            else if (c >= 150 && c < 158) { if (i == 5) L = 1024 + (c + 98); else if (i > 5) return false; }
            else if (L >= 1430) return false;
            if (L < 22) { u.pm = 64; u.pn = (int)L; return true; }
            L -= 22;
        }
        if (L >= nwg) return false;
        int wgid = (int)L; { const int q = nwg / NXCD, r = nwg % NXCD, xcd = wgid % NXCD, off = wgid / NXCD; wgid = (xcd < r ? xcd * (q + 1) : r * (q + 1) + (xcd - r) * q) + off; }
        const int nig = WGM * nN, gid = wgid / nig, fm = gid * WGM, gsz = (nM - fm) < WGM ? (nM - fm) : WGM;
        u.pm = fm + ((wgid % nig) % gsz); u.pn = (wgid % nig) / gsz; return true;
    }
};

template <class Epi>
__device__ __forceinline__ void gemm_phase(LAS unsigned char* lds, const Gemm g, const StaticOrder& S, const Epi& E) {
    int tid_ = threadIdx.x; asm volatile("" : "+v"(tid_));
    const int tid = tid_, wid = __builtin_amdgcn_readfirstlane(tid >> 6), lane = tid & 63, wr = wid >> 2, wc = wid & 3, fr = lane & 15, fq = lane >> 4;
    const int K = g.K, nt = K / BK;
    unsigned voffA[2], voffB[2];
#pragma unroll
    for (int i = 0; i < 2; ++i) { int R, C; stage_rc(tid * 16 + i * 8192, R, C); const int Rb = Epi::PERM ? ((R & ~31) + perm32(R & 31)) : R;
        voffA[i] = (unsigned)(R * g.lda + C) * 2u; voffB[i] = (unsigned)(Rb * g.ldb + C) * 2u; }
    const size_t kstep = (size_t)(BK * 2);
    const size_t hstepA = (size_t)HALF * g.lda * 2, hstepB = (size_t)HALF * g.ldb * 2;
    const size_t tstepA = 2 * hstepA, tstepB = 2 * hstepB;
    const unsigned ldsw = (unsigned)wid * 1024u;
    const int aoff = lds_byte(wr * 64 + fr, fq * 8), boff = lds_byte(wc * 32 + fr, fq * 8);
#define PG8_SA(b, h) (((b) * 2 + (h)) * HTB)
#define PG8_SB(b, h) ((4 + (b) * 2 + (h)) * HTB)
#define PG8_STAGE(bufoff, gbase, voff) do { _Pragma("unroll") for (int _i = 0; _i < 2; ++_i) \
        __builtin_amdgcn_global_load_lds((const unsigned*)((const char*)(gbase) + (voff)[_i]), (LAS unsigned*)(lds + (bufoff) + ldsw + _i * 8192), 16, 0, 0); } while (0)
#define PG8_LDA(dst, b, h) do { _Pragma("unroll") for (int m = 0; m < 4; ++m) _Pragma("unroll") for (int k = 0; k < 2; ++k) dst[m][k] = *(const LAS bf16x8*)(lds + PG8_SA(b, h) + aoff + m * 2048 + k * 1024); } while (0)
#define PG8_LDB(dst, b, h) do { _Pragma("unroll") for (int n = 0; n < 2; ++n) _Pragma("unroll") for (int k = 0; k < 2; ++k) dst[n][k] = *(const LAS bf16x8*)(lds + PG8_SB(b, h) + boff + n * 2048 + k * 1024); } while (0)
#define PG8_MMA(ai, bj, At, Bt) do { __builtin_amdgcn_s_setprio(1); _Pragma("unroll") for (int m = 0; m < 4; ++m) _Pragma("unroll") for (int n = 0; n < 2; ++n) _Pragma("unroll") for (int k = 0; k < 2; ++k) \
        acc[ai][bj][m][n] = __builtin_amdgcn_mfma_f32_16x16x32_bf16(Bt[n][k], At[m][k], acc[ai][bj][m][n], 0, 0, 0); __builtin_amdgcn_s_setprio(0); } while (0)
#define PG8_WAIT_V(n) asm volatile("s_waitcnt vmcnt(" #n ")" ::: "memory")
#define PG8_WAIT_L(n) asm volatile("s_waitcnt lgkmcnt(" #n ")" ::: "memory")
#define PG8_BAR __builtin_amdgcn_s_barrier()
#define PG8_SCHED __builtin_amdgcn_sched_barrier(0)
    Unit cur, nxt; int ui = 0;
    if (!S.next(0, cur)) return;
    f32x4 acc[2][2][4][2];
#pragma unroll
    for (int a = 0; a < 2; ++a)
#pragma unroll
        for (int b = 0; b < 2; ++b)
#pragma unroll
            for (int m = 0; m < 4; ++m)
#pragma unroll
                for (int n = 0; n < 2; ++n) acc[a][b][m][n] = (f32x4){0.f, 0.f, 0.f, 0.f};
    bf16x8 At[4][2], B0[2][2], B1[2][2];
#define PG8_ABASE(u) ((const char*)g.A + (size_t)((u).pm + g.pm0) * tstepA + ((size_t)((u).pn % g.nNr) * g.apn + (size_t)((u).pn / g.nNr) * K) * 2)
#define PG8_BBASE(u) ((const char*)g.Bt + (size_t)((u).pn % g.nNr) * tstepB + (size_t)((u).pn / g.nNr) * K * 2)
    const char* cA = PG8_ABASE(cur); const char* cB = PG8_BBASE(cur);
    PG8_STAGE(PG8_SB(0, 0), cB, voffB); PG8_STAGE(PG8_SA(0, 0), cA, voffA); PG8_STAGE(PG8_SB(0, 1), cB + hstepB, voffB); PG8_STAGE(PG8_SA(0, 1), cA + hstepA, voffA);
    if (wr == 1) PG8_BAR;
    PG8_WAIT_V(4); PG8_BAR;
    PG8_STAGE(PG8_SB(1, 0), cB + kstep, voffB); PG8_STAGE(PG8_SA(1, 0), cA + kstep, voffA); PG8_STAGE(PG8_SB(1, 1), cB + hstepB + kstep, voffB);
    PG8_WAIT_V(6); PG8_BAR;
    for (;;) {
        const bool has_next = S.next(ui + 1, nxt);
        const char* nA = has_next ? PG8_ABASE(nxt) : cA; const char* nB = has_next ? PG8_BBASE(nxt) : cB;
        for (int t = 0; t < nt; t += 2) {
            const bool last = (t == nt - 2);
            const char* a1 = cA + (size_t)(t + 1) * kstep;
            const char* a2 = last ? nA : cA + (size_t)(t + 2) * kstep; const char* b2 = last ? nB : cB + (size_t)(t + 2) * kstep;
            const char* a3 = a2 + kstep; const char* b3 = b2 + kstep;
            PG8_LDB(B0, 0, 0); PG8_SCHED; PG8_LDA(At, 0, 0); PG8_STAGE(PG8_SA(1, 1), a1 + hstepA, voffA);
            PG8_WAIT_L(8); PG8_BAR; PG8_WAIT_L(0); PG8_MMA(0, 0, At, B0); PG8_BAR; PG8_SCHED;
            PG8_LDB(B1, 0, 1); PG8_STAGE(PG8_SB(0, 0), b2, voffB);
            PG8_BAR; PG8_WAIT_L(0); PG8_MMA(0, 1, At, B1); PG8_BAR;
            PG8_LDA(At, 0, 1); PG8_STAGE(PG8_SA(0, 0), a2, voffA);
            PG8_BAR; PG8_WAIT_L(0); PG8_MMA(1, 0, At, B0); PG8_BAR; PG8_SCHED;
            PG8_STAGE(PG8_SB(0, 1), b2 + hstepB, voffB);
            PG8_WAIT_V(6); PG8_BAR; PG8_MMA(1, 1, At, B1); PG8_BAR;
            PG8_LDB(B0, 1, 0); PG8_SCHED; PG8_LDA(At, 1, 0); PG8_STAGE(PG8_SA(0, 1), a2 + hstepA, voffA);
            PG8_WAIT_L(8); PG8_BAR; PG8_WAIT_L(0); PG8_MMA(0, 0, At, B0); PG8_BAR; PG8_SCHED;
            PG8_LDB(B1, 1, 1); PG8_STAGE(PG8_SB(1, 0), b3, voffB);
            PG8_BAR; PG8_WAIT_L(0); PG8_MMA(0, 1, At, B1); PG8_BAR;
            PG8_LDA(At, 1, 1); PG8_STAGE(PG8_SA(1, 0), a3, voffA);
            PG8_BAR; PG8_WAIT_L(0); PG8_MMA(1, 0, At, B0); PG8_BAR; PG8_SCHED;
            PG8_STAGE(PG8_SB(1, 1), b3 + hstepB, voffB);
            PG8_WAIT_V(6); PG8_BAR; PG8_MMA(1, 1, At, B1); PG8_BAR;
        }
        { Unit eu; eu.pm = cur.pm + g.pm0; eu.pn = cur.pn; E(acc, eu, wr, wc, fr, fq); }
        if (!has_next) break;
#pragma unroll
        for (int a = 0; a < 2; ++a)
#pragma unroll
            for (int b = 0; b < 2; ++b)
#pragma unroll
                for (int m = 0; m < 4; ++m)
#pragma unroll
                    for (int n = 0; n < 2; ++n) acc[a][b][m][n] = (f32x4){0.f, 0.f, 0.f, 0.f};
        cur = nxt; cA = nA; cB = nB; ++ui;
    }
    PG8_WAIT_V(0);
    if (wr == 0) PG8_BAR;
    PG8_BAR;
#undef PG8_ABASE
#undef PG8_BBASE
#undef PG8_SA
#undef PG8_SB
#undef PG8_STAGE
#undef PG8_LDA
#undef PG8_LDB
#undef PG8_MMA
#undef PG8_WAIT_V
#undef PG8_WAIT_L
#undef PG8_BAR
#undef PG8_SCHED
}

struct EpiGU {
    static constexpr bool PERM = true;
    bf16_t* ACT; const u64* ss; unsigned* cnt;
    __device__ __forceinline__ void operator()(const f32x4 (&acc)[2][2][4][2], const Unit& u, int wr, int wc, int fr, int fq) const {
        const int row0 = u.pm * BM + wr * 64 + fr, col0 = u.pn * 128 + wc * 32 + 8 * fq;
        if (cnt && u.pm == 64) {
            const __amdgpu_buffer_rsrc_t rsrc = __builtin_amdgcn_make_buffer_rsrc(ACT, 0, M * FF * 2, 0x00020000);
#pragma unroll
            for (int m = 0; m < 4; ++m) {
                const int r = row0 + m * 16; const float rs = SS_RS(ss[r]);
                float o[8];
#pragma unroll
                for (int n = 0; n < 2; ++n)
#pragma unroll
                    for (int j = 0; j < 4; ++j) { const float gg = acc[0][0][m][n][j] * rs, uu = acc[0][1][m][n][j] * rs; o[4 * n + j] = silu(gg) * uu; }
                __builtin_amdgcn_raw_buffer_store_b128(pack8(o), rsrc, (unsigned)(((size_t)r * FF + col0) * 2), 0, 16);
            }
            asm volatile("s_waitcnt vmcnt(0)" ::: "memory");
            if (fr == 0 && fq == 0) (void)__hip_atomic_fetch_add(cnt, 1u, __ATOMIC_RELAXED, __HIP_MEMORY_SCOPE_AGENT);
            return;
        }
        u64 sv[2][4]; float rsv[2][4];
#pragma unroll
        for (int ai = 0; ai < 2; ++ai)
#pragma unroll
            for (int m = 0; m < 4; ++m) sv[ai][m] = ss[row0 + ai * HALF + m * 16];
#pragma unroll
        for (int ai = 0; ai < 2; ++ai)
#pragma unroll
            for (int m = 0; m < 4; ++m) rsv[ai][m] = SS_RS(sv[ai][m]);
#pragma unroll
        for (int ai = 0; ai < 2; ++ai)
#pragma unroll
            for (int m = 0; m < 4; ++m) {
                const int r = row0 + ai * HALF + m * 16; const float rs = rsv[ai][m];
                float o[8];
#pragma unroll
                for (int n = 0; n < 2; ++n)
#pragma unroll
                    for (int j = 0; j < 4; ++j) { const float gg = acc[ai][0][m][n][j] * rs, uu = acc[ai][1][m][n][j] * rs; o[4 * n + j] = silu(gg) * uu; }
                *(u32x4*)(ACT + (size_t)r * FF + col0) = pack8(o);
            }
    }
};
struct EpiX {
    static constexpr bool PERM = true;
    float* X; bf16_t* XB; u64* ssn; const float* scale; float alpha;
    __device__ __forceinline__ void operator()(const f32x4 (&acc)[2][2][4][2], const Unit& u, int wr, int wc, int fr, int fq) const {
        const int row0 = u.pm * BM + wr * 64 + fr, col0 = u.pn * BM + wc * 32 + 8 * fq;
#pragma unroll
        for (int ai = 0; ai < 2; ++ai)
#pragma unroll
            for (int mp = 0; mp < 4; mp += 2) {
                f32x4 xv[2][2][2];
#pragma unroll
                for (int mm = 0; mm < 2; ++mm)
#pragma unroll
                    for (int bj = 0; bj < 2; ++bj) { const float* xp = X + (size_t)(row0 + ai * HALF + (mp + mm) * 16) * D + col0 + bj * HALF; xv[mm][bj][0] = *(const f32x4*)xp; xv[mm][bj][1] = *(const f32x4*)(xp + 4); }
#pragma unroll
                for (int mm = 0; mm < 2; ++mm) {
                    const int m = mp + mm;
                    const int r = row0 + ai * HALF + m * 16; const bool ok = r < MR; float sq = 0.f;
#pragma unroll
                    for (int bj = 0; bj < 2; ++bj) {
                        const int c = col0 + bj * HALF; float* xp = X + (size_t)r * D + c;
                        f32x4 y0 = acc[ai][bj][m][0] * alpha, y1 = acc[ai][bj][m][1] * alpha;
                        if (scale) { y0 = y0 * *(const f32x4*)(scale + c); y1 = y1 * *(const f32x4*)(scale + c + 4); }
                        const f32x4 x0 = xv[mm][bj][0] + y0, x1 = xv[mm][bj][1] + y1;
                        if (ok) {
                            *(f32x4*)xp = x0; *(f32x4*)(xp + 4) = x1;
                            u32x4 w; w.x = pk2(x0.x, x0.y); w.y = pk2(x0.z, x0.w); w.z = pk2(x1.x, x1.y); w.w = pk2(x1.z, x1.w);
                            *(u32x4*)(XB + (size_t)r * D + c) = w;
                            sq += (x0.x * x0.x + x0.y * x0.y) + (x0.z * x0.z + x0.w * x0.w) + (x1.x * x1.x + x1.y * x1.y) + (x1.z * x1.z + x1.w * x1.w);
                        }
                    }
                    sq += __shfl_xor(sq, 16); sq += __shfl_xor(sq, 32);
                    if (ok && fq == 0) atomicAdd(ssn + r, (u64)(sq * 16777216.f + 0.5f));
                }
            }
    }
};
struct EpiSplitX {
    static constexpr bool PERM = true;
    EpiX inner; float* part; unsigned* tick; int nNr;
    __device__ __forceinline__ void operator()(const f32x4 (&acc)[2][2][4][2], const Unit& u, int wr, int wc, int fr, int fq) const {
        const int pn_r = u.pn % nNr, ks = u.pn / nNr, wave = wr * 4 + wc, lane = fq * 16 + fr;
        const __amdgpu_buffer_rsrc_t rsrc = __builtin_amdgcn_make_buffer_rsrc(part, 0, 4 * 2 * 8 * 16 * 256 * 4, 0x00020000);
        const unsigned moff = (unsigned)((((pn_r * 2 + ks) * 8 + wave) * 16) * 256 + lane * 4) * 4u;
#pragma unroll
        for (int bj = 0; bj < 2; ++bj)
#pragma unroll
            for (int m = 0; m < 4; ++m)
#pragma unroll
                for (int n = 0; n < 2; ++n) __builtin_amdgcn_raw_buffer_store_b128(__builtin_bit_cast(u32x4, acc[0][bj][m][n]), rsrc, moff + (unsigned)(((bj * 4 + m) * 2 + n) * 1024), 0, 16);
        asm volatile("s_waitcnt vmcnt(0)" ::: "memory");
        unsigned old = 0u;
        if (lane == 0) old = __hip_atomic_fetch_add(tick + pn_r * 8 + wave, 1u, __ATOMIC_RELAXED, __HIP_MEMORY_SCOPE_AGENT);
        old = (unsigned)__builtin_amdgcn_readfirstlane((int)old);
        if (old == 1u) {
            __builtin_amdgcn_fence(__ATOMIC_ACQUIRE, "agent");
            asm volatile("s_waitcnt vmcnt(0)" ::: "memory");
            const float* src = part + ((size_t)((pn_r * 2 + (ks ^ 1)) * 8 + wave) * 16) * 256 + lane * 4;
            f32x4 sum[2][2][4][2];
#pragma unroll
            for (int bj = 0; bj < 2; ++bj)
#pragma unroll
                for (int m = 0; m < 4; ++m)
#pragma unroll
                    for (int n = 0; n < 2; ++n) { sum[0][bj][m][n] = acc[0][bj][m][n] + *(const f32x4*)(src + (((bj * 4 + m) * 2 + n) * 256)); sum[1][bj][m][n] = (f32x4){0.f, 0.f, 0.f, 0.f}; }
            Unit iu; iu.pm = u.pm; iu.pn = pn_r;
            inner(sum, iu, wr, wc, fr, fq);
        }
    }
};
struct EpiP {
    static constexpr bool PERM = true;
    bf16_t* P16; float* LOGG; const u64* ss; const float* lbraw; int e;
    template <int MODE>
    __device__ __forceinline__ void run(const f32x4 (&acc)[2][2][4][2], int row0, int col0) const {
        u64 sv[2][4]; float rsv[2][4];
#pragma unroll
        for (int ai = 0; ai < 2; ++ai)
#pragma unroll
            for (int m = 0; m < 4; ++m) sv[ai][m] = ss[row0 + ai * HALF + m * 16];
#pragma unroll
        for (int ai = 0; ai < 2; ++ai)
#pragma unroll
            for (int m = 0; m < 4; ++m) rsv[ai][m] = SS_RS(sv[ai][m]);
#pragma unroll
        for (int ai = 0; ai < 2; ++ai) {
#pragma unroll
            for (int m = 0; m < 4; ++m) {
                const int r = row0 + ai * HALF + m * 16; const float rs = rsv[ai][m];
#pragma unroll
                for (int bj = 0; bj < 2; ++bj) {
                    const int c = col0 + bj * HALF; float v[8];
#pragma unroll
                    for (int n = 0; n < 2; ++n) {
#pragma unroll
                        for (int j = 0; j < 4; ++j) v[4 * n + j] = acc[ai][bj][m][n][j] * rs;
                    }
                    if (MODE == 0) {
#pragma unroll
                        for (int i = 0; i < 8; ++i) v[i] = silu(v[i]) * 0.08838834764831845f;
                    }
                    if (MODE == 1) {
                        const int ch = c - 512; float lg[8];
                        const f32x4 l0a = *(const f32x4*)(lbraw + ch), l0b = *(const f32x4*)(lbraw + ch + 4), l1a = *(const f32x4*)(lbraw + 512 + ch), l1b = *(const f32x4*)(lbraw + 512 + ch + 4);
                        const float dl[8] = {l0a.x - l1a.x, l0a.y - l1a.y, l0a.z - l1a.z, l0a.w - l1a.w, l0b.x - l1b.x, l0b.y - l1b.y, l0b.z - l1b.z, l0b.w - l1b.w};
#pragma unroll
                        for (int i = 0; i < 8; ++i) {
                            const float x = v[i];
                            const float lsg = fminf(x, 0.f) - __logf(1.f + __expf(-fabsf(x)));
                            const float sg = __expf(lsg);
                            const float lb = (e == 0) ? 0.f : __builtin_amdgcn_rcpf(1.f + __expf(dl[i]));
                            const float gg = lb + (1.f - lb) * sg;
                            lg[i] = (e == 0) ? lsg : __logf(gg); v[i] = 1.f - gg;
                        }
                        float* lp = LOGG + (size_t)r * 512 + ch;
                        *(f32x4*)lp = (f32x4){lg[0], lg[1], lg[2], lg[3]}; *(f32x4*)(lp + 4) = (f32x4){lg[4], lg[5], lg[6], lg[7]};
                    }
                    *(u32x4*)(P16 + (size_t)r * 4096 + c) = pack8(v);
                }
            }
        }
    }
    __device__ __forceinline__ void operator()(const f32x4 (&acc)[2][2][4][2], const Unit& u, int wr, int wc, int fr, int fq) const {
        const int row0 = u.pm * BM + wr * 64 + fr, col0 = u.pn * BM + wc * 32 + 8 * fq;
        const int region = u.pn >> 1;
        if (region == 0) run<0>(acc, row0, col0); else if (region == 1) run<1>(acc, row0, col0); else run<2>(acc, row0, col0);
    }
};
struct EpiU {
    static constexpr bool PERM = true;
    bf16_t* U; const u64* ss;
    __device__ __forceinline__ void operator()(const f32x4 (&acc)[2][2][4][2], const Unit& u, int wr, int wc, int fr, int fq) const {
        const int row0 = u.pm * BM + wr * 64 + fr, col0 = u.pn * BM + wc * 32 + 8 * fq;
        u64 sv[2][4]; float rsv[2][4];
#pragma unroll
        for (int ai = 0; ai < 2; ++ai)
#pragma unroll
            for (int m = 0; m < 4; ++m) sv[ai][m] = ss[row0 + ai * HALF + m * 16];
#pragma unroll
        for (int ai = 0; ai < 2; ++ai)
#pragma unroll
            for (int m = 0; m < 4; ++m) rsv[ai][m] = SS_RS(sv[ai][m]);
#pragma unroll
        for (int ai = 0; ai < 2; ++ai)
#pragma unroll
            for (int m = 0; m < 4; ++m) {
                const int r = row0 + ai * HALF + m * 16; const float rs = rsv[ai][m];
#pragma unroll
                for (int bj = 0; bj < 2; ++bj) {
                    float v[8];
#pragma unroll
                    for (int n = 0; n < 2; ++n)
#pragma unroll
                        for (int j = 0; j < 4; ++j) v[4 * n + j] = acc[ai][bj][m][n][j] * rs;
                    *(u32x4*)(U + (size_t)r * D + col0 + bj * HALF) = pack8(v);
                }
            }
    }
};
}

__device__ __forceinline__ void tr_item(const float* W, int ldw, const float* nw, bf16_t* WT, int ldk, int k0, int nsrc0, int rowdst0, LAS float* scr, int lane) {
#pragma unroll
    for (int i = 0; i < 32; ++i) { const int kk = 2 * i + (lane >> 5); const float s = nw ? nw[k0 + kk] : 1.f; scr[kk * 33 + (lane & 31)] = __builtin_nontemporal_load(W + (size_t)(k0 + kk) * ldw + nsrc0 + (lane & 31)) * s; }
    LDS_WAIT();
    const int c = lane & 7;
#pragma unroll
    for (int j = 0; j < 4; ++j) { const int n = (lane >> 3) + 8 * j; const LAS float* s = scr + (8 * c) * 33 + n;
        u32x4 o; o.x = pk2(s[0 * 33], s[1 * 33]); o.y = pk2(s[2 * 33], s[3 * 33]); o.z = pk2(s[4 * 33], s[5 * 33]); o.w = pk2(s[6 * 33], s[7 * 33]);
        *(u32x4*)(WT + (size_t)(rowdst0 + n) * ldk + k0 + 8 * c) = o; }
    LDS_WAIT();
}

__device__ __forceinline__ void convert_layer(const Params& p, LAS float* scr, int li, int worker, int nworkers, int lane) {
    unsigned char* ws = p.ws;
    const int nmix = (li & 1) ? 640 : 2560, total = 8448 + nmix;
    for (int it = worker; it < total; it += nworkers) {
        if (it < 8448) {
            const int idx = it / 1408, rr = it % 1408, which = idx / 3, mat = idx % 3, f = li * 2 + which;
            if (mat < 2) {
                const float* W = p.in[which ? (mat ? 24 : 23) : (mat ? 19 : 18)] + (size_t)li * D * FF;
                const float* nw = p.in[which ? 22 : 17] + li * D;
                const int kb = rr / 88, nb = rr % 88, n0 = nb * 32;
                tr_item(W, FF, nw, (bf16_t*)(ws + WS_WGU + f * SZ_WGU), D, kb * 64, n0, 256 * (n0 >> 7) + (mat ? 128 : 0) + (n0 & 127), scr, lane);
            } else {
                const float* W = p.in[which ? 25 : 20] + (size_t)li * FF * D;
                const int kb = rr / 32, nb = rr % 32;
                tr_item(W, D, nullptr, (bf16_t*)(ws + WS_WD + f * SZ_WD), FF, kb * 64, nb * 32, nb * 32, scr, lane);
            }
        } else if (!(li & 1)) {
            const int e = li >> 1; int rr = it - 8448;
            if (rr < 2048) { const int kb = rr / 128, nb = rr % 128;
                tr_item(p.in[7] + (size_t)e * D * 4104, 4104, p.in[21] + (2 * e) * D, (bf16_t*)(ws + WS_WIN + e * SZ_WIN), D, kb * 64, nb * 32, nb * 32, scr, lane);
            } else { rr -= 2048; const int kb = rr / 32, nb = rr % 32;
                tr_item(p.in[13] + (size_t)e * D * D, D, nullptr, (bf16_t*)(ws + WS_WOUT + e * SZ_W1K), D, kb * 64, nb * 32, nb * 32, scr, lane); }
        } else {
            const int o = li >> 1; int rr = it - 8448;
            if (rr < 512) { const int kb = rr / 32, nb = rr % 32;
                tr_item(p.in[14] + (size_t)o * D * D, D, p.in[21] + (2 * o + 1) * D, (bf16_t*)(ws + WS_WP + o * SZ_W1K), D, kb * 64, nb * 32, nb * 32, scr, lane);
            } else { rr -= 512; const int gq = rr / 32, r2 = rr % 32, kb = r2 / 8, nb = r2 % 8;
                tr_item(p.in[15] + (size_t)(o * 4 + gq) * 65536, 256, nullptr, (bf16_t*)(ws + WS_WGRP + o * SZ_WGRP), 256, kb * 64, nb * 32, gq * 256 + nb * 32, scr, lane); }
        }
    }
    if (!(li & 1)) {
        const int e = li >> 1; float* WAB = (float*)(ws + WS_WAB) + e * 8192;
        for (int i = worker * 64 + lane; i < 8192; i += nworkers * 64) { const int j = i >> 10, k = i & 1023; WAB[i] = p.in[7][(size_t)e * D * 4104 + (size_t)k * 4104 + 4096 + j] * p.in[21][(2 * e) * D + k]; }
    }
}

__device__ __forceinline__ void phase_prep(const Params& p, LAS unsigned char* lds) {
    int tid_ = threadIdx.x; asm volatile("" : "+v"(tid_));
    { unsigned lb_ = (unsigned)(size_t)lds; asm volatile("" : "+v"(lb_)); lds = (LAS unsigned char*)(size_t)lb_; }
    const int tid = tid_, lane = tid & 63, wave = tid >> 6;
    const int gw = blockIdx.x * 8 + wave, NGW = gridDim.x * 8;
    unsigned char* ws = p.ws;
    LAS float* scr = (LAS float*)(lds + wave * 8448);
    convert_layer(p, scr, 0, gw, NGW, lane);
    if (gridDim.x <= 64) { for (int li = 1; li < 4; ++li) convert_layer(p, scr, li, gw, NGW, lane); }
    const int gt = blockIdx.x * 512 + tid, NGT = gridDim.x * 512;
    u64* SS = (u64*)(ws + WS_SS);
    for (int i = gt; i < 12 * M; i += NGT) SS[M + i] = 0ull;
    for (int i = gt; i < M - MR; i += NGT) SS[MR + i] = 0ull;
    bf16_t* XB = (bf16_t*)(ws + WS_XB);
    for (int r = gw; r < M; r += NGW) {
        if (r < MR) {
            const float* src = (r < MP) ? p.in[0] + (size_t)r * D : p.in[1] + (size_t)(r - MP) * D;
            float* dst = p.out + (size_t)r * D; float s = 0.f;
#pragma unroll
            for (int j = 0; j < 4; ++j) { const int c = 4 * lane + 256 * j; const f32x4 v = *(const f32x4*)(src + c); *(f32x4*)(dst + c) = v;
                u32x2 w; w.x = pk2(v.x, v.y); w.y = pk2(v.z, v.w); *(u32x2*)(XB + (size_t)r * D + c) = w; s += (v.x * v.x + v.y * v.y) + (v.z * v.z + v.w * v.w); }
            s = wave_sum(s); if (lane == 0) SS[r] = (u64)(s * 16777216.f + 0.5f);
        } else {
#pragma unroll
            for (int j = 0; j < 4; ++j) { const int c = 4 * lane + 256 * j; *(u32x2*)(XB + (size_t)r * D + c) = (u32x2){0u, 0u}; }
        }
    }
}

__device__ __forceinline__ void phase_ab(const Params& p, int e, const u64* ss) {
    int tid_ = threadIdx.x; asm volatile("" : "+v"(tid_));
    const int tid = tid_, lane = tid & 63, wave = tid >> 6;
    const int skip = (gridDim.x == 256) ? 16 : 0;
    if ((int)blockIdx.x < skip) return;
    const int gw = ((int)blockIdx.x - skip) * 8 + wave, NGW = ((int)gridDim.x - skip) * 8;
    const bf16_t* XB = (const bf16_t*)(p.ws + WS_XB); const float* WAB = (const float*)(p.ws + WS_WAB) + e * 8 * 1024; float* AB = (float*)(p.ws + WS_AB);
    for (int r = gw; r < MR; r += NGW) {
        float x[16]; const bf16_t* xp = XB + (size_t)r * D + 16 * lane;
        unpack8(*(const u32x4*)xp, x); unpack8(*(const u32x4*)(xp + 8), x + 8);
        const float rs = SS_RS(ss[r]);
        float sj[8];
#pragma unroll
        for (int j = 0; j < 8; ++j) {
            const float* w = WAB + j * 1024 + 16 * lane; float s = 0.f;
#pragma unroll
            for (int i = 0; i < 4; ++i) { const f32x4 wv = *(const f32x4*)(w + 4 * i); s += x[4 * i] * wv.x + x[4 * i + 1] * wv.y + x[4 * i + 2] * wv.z + x[4 * i + 3] * wv.w; }
            sj[j] = s;
        }
#pragma unroll
        for (int j = 0; j < 8; ++j) sj[j] = wave_sum(sj[j]) * rs;
        if (lane == 0) { float* ap = AB + (size_t)r * 8; *(f32x4*)ap = (f32x4){sj[0], sj[1], sj[2], sj[3]}; *(f32x4*)(ap + 4) = (f32x4){sj[4], sj[5], sj[6], sj[7]}; }
    }
}

__device__ __forceinline__ void e2_gdn(const Params& p, LAS unsigned char* lds, int e, int item) {
    int tid_ = threadIdx.x; asm volatile("" : "+v"(tid_));
    { unsigned lb_ = (unsigned)(size_t)lds; asm volatile("" : "+v"(lb_)); lds = (LAS unsigned char*)(size_t)lb_; }
    const int tid = tid_, lane = tid & 63, wave = tid >> 6, fr = lane & 15, fq = lane >> 4;
    const int seq = item >> 5, n = item & 31, b = seq >> 2, h = seq & 3;
    const int t = tid >> 3, sub = tid & 7, c0 = sub * 16;
    const int tpos = n * 64 + t; const size_t r = (size_t)b * TP + tpos;
    LAS bf16_t* Qs = (LAS bf16_t*)(lds); LAS bf16_t* Ks = (LAS bf16_t*)(lds + 17408); LAS bf16_t* KBT = (LAS bf16_t*)(lds + 34816); LAS bf16_t* VBT = (LAS bf16_t*)(lds + 53248);
    LAS bf16_t* Tm = (LAS bf16_t*)(lds + 71680); LAS float* Af = (LAS float*)(lds + 80896); LAS float* gv = (LAS float*)(lds + 98304); LAS float* bv = gv + 64; LAS float* btv = gv + 128;
    const bf16_t* P16 = (const bf16_t*)(p.ws + WS_P16); const float* AB = (const float*)(p.ws + WS_AB);
    unsigned char* blk = p.ws + WS_E2G + (size_t)item * E2G_BYTES;
    bf16_t* uT = (bf16_t*)blk; bf16_t* wF = (bf16_t*)(blk + 16384); bf16_t* qF = (bf16_t*)(blk + 32768); bf16_t* kF = (bf16_t*)(blk + 49152); bf16_t* aF = (bf16_t*)(blk + 65536); float* dec = (float*)(blk + 73728);
    if (sub == 0) {
        const float a = AB[r * 8 + h], bb = AB[r * 8 + 4 + h];
        const float Ah = __expf(p.in[10][e * 4 + h]); const float x = a + p.in[11][e * 4 + h];
        const float sp = x > 20.f ? x : log1pf(__expf(x));
        gv[t] = -Ah * sp; btv[t] = sigm(bb);
    }
    float qv[16], kv[16], vv[16];
    const float* cw = p.in[9] + (size_t)e * 4 * 1536;
#pragma unroll
    for (int part = 0; part < 3; ++part) {
        float a[16];
#pragma unroll
        for (int i = 0; i < 16; ++i) a[i] = 0.f;
        const int ch = part * 512 + h * 128 + c0;
        if (n > 0) {
#pragma unroll
        for (int j = 0; j < 4; ++j) {
            {
                const bf16_t* src = P16 + (r - 3 + j) * 4096 + 2048 + ch; float x[16];
                unpack8(*(const u32x4*)src, x); unpack8(*(const u32x4*)(src + 8), x + 8);
                const float* w = cw + j * 1536 + ch;
#pragma unroll
                for (int i = 0; i < 4; ++i) { const f32x4 wv = *(const f32x4*)(w + 4 * i); a[4 * i] += x[4 * i] * wv.x; a[4 * i + 1] += x[4 * i + 1] * wv.y; a[4 * i + 2] += x[4 * i + 2] * wv.z; a[4 * i + 3] += x[4 * i + 3] * wv.w; }
            }
        }
        } else {
#pragma unroll
        for (int j = 0; j < 4; ++j) {
            if (tpos - 3 + j >= 0) {
                const bf16_t* src = P16 + (r - 3 + j) * 4096 + 2048 + ch; float x[16];
                unpack8(*(const u32x4*)src, x); unpack8(*(const u32x4*)(src + 8), x + 8);
                const float* w = cw + j * 1536 + ch;
#pragma unroll
                for (int i = 0; i < 4; ++i) { const f32x4 wv = *(const f32x4*)(w + 4 * i); a[4 * i] += x[4 * i] * wv.x; a[4 * i + 1] += x[4 * i + 1] * wv.y; a[4 * i + 2] += x[4 * i + 2] * wv.z; a[4 * i + 3] += x[4 * i + 3] * wv.w; }
            }
        }
        }
#pragma unroll
        for (int i = 0; i < 16; ++i) { const float s = silu(a[i]); if (part == 0) qv[i] = s; else if (part == 1) kv[i] = s; else vv[i] = s; }
    }
    if (n == 31 && t >= 61) {
#pragma unroll
        for (int part = 0; part < 3; ++part) {
            const int ch = part * 512 + h * 128 + c0; const bf16_t* src = P16 + r * 4096 + 2048 + ch; float x[16];
            unpack8(*(const u32x4*)src, x); unpack8(*(const u32x4*)(src + 8), x + 8);
            float* o = p.out + O_CVP + ((size_t)(e * NB + b) * 3 + (t - 61)) * 1536 + ch;
#pragma unroll
            for (int i = 0; i < 4; ++i) *(f32x4*)(o + 4 * i) = (f32x4){x[4 * i], x[4 * i + 1], x[4 * i + 2], x[4 * i + 3]};
        }
    }
    float qs = 0.f, ks = 0.f;
#pragma unroll
    for (int i = 0; i < 16; ++i) { qs += qv[i] * qv[i]; ks += kv[i] * kv[i]; }
    qs += __shfl_xor(qs, 1); qs += __shfl_xor(qs, 2); qs += __shfl_xor(qs, 4);
    ks += __shfl_xor(ks, 1); ks += __shfl_xor(ks, 2); ks += __shfl_xor(ks, 4);
    const float qn = rsqrtf(qs + EPS) * 0.08838834764831845f, kn = rsqrtf(ks + EPS);
    __syncthreads();
    if (wave == 0) {
        float x = gv[lane];
#pragma unroll
        for (int o = 1; o < 64; o <<= 1) { const float y = __shfl_up(x, o); if (lane >= o) x += y; }
        bv[lane] = x;
    }
    __syncthreads();
    const float bt = bv[t], bl = bv[63];
    const float beta = btv[t], ebt = __expf(bt), ekl = __expf(bl - bt);
    if (tid == 0) dec[0] = __expf(bl);
    {
        float tq[16], tk[16], tqq[16];
#pragma unroll
        for (int i = 0; i < 16; ++i) { tq[i] = qv[i] * qn; tk[i] = kv[i] * kn; tqq[i] = tq[i] * ebt; }
        *(LAS u32x4*)(Qs + t * 136 + c0) = pack8(tq); *(LAS u32x4*)(Qs + t * 136 + c0 + 8) = pack8(tq + 8);
        *(LAS u32x4*)(Ks + t * 136 + c0) = pack8(tk); *(LAS u32x4*)(Ks + t * 136 + c0 + 8) = pack8(tk + 8);
        *(u32x4*)(qF + fo_off(t, c0, 4)) = pack8(tqq); *(u32x4*)(qF + fo_off(t, c0 + 8, 4)) = pack8(tqq + 8);
#pragma unroll
        for (int i = 0; i < 16; ++i) {
            KBT[(c0 + i) * 72 + t] = f2bf(tk[i] * beta * ebt);
            VBT[(c0 + i) * 72 + t] = f2bf(vv[i] * beta);
            kF[fo_off(c0 + i, t, 2)] = f2bf(tk[i] * ekl);
        }
    }
    __syncthreads();
#pragma unroll
    for (int q2 = 0; q2 < 2; ++q2) {
        const int id = 2 * wave + q2, mt = id >> 2, nt = id & 3;
        f32x4 a1 = {0.f, 0.f, 0.f, 0.f}, a2 = {0.f, 0.f, 0.f, 0.f};
#pragma unroll
        for (int ks4 = 0; ks4 < 4; ++ks4) {
            const bf16x8 km = *(const LAS bf16x8*)(Ks + (16 * mt + fr) * 136 + 32 * ks4 + 8 * fq);
            const bf16x8 kn2 = *(const LAS bf16x8*)(Ks + (16 * nt + fr) * 136 + 32 * ks4 + 8 * fq);
            const bf16x8 qn2 = *(const LAS bf16x8*)(Qs + (16 * nt + fr) * 136 + 32 * ks4 + 8 * fq);
            a1 = mfma16(km, kn2, a1);
            a2 = mfma16(km, qn2, a2);
        }
        {
            const int s = 16 * nt + fr; const float bs = bv[s];
#pragma unroll
            for (int j = 0; j < 4; ++j) { const int tt = 16 * mt + 4 * fq + j; Af[tt * 68 + s] = (s < tt) ? btv[tt] * a1[j] * __expf(bv[tt] - bs) : 0.f; }
        }
        {
            const int tt = 16 * nt + fr; const float btt = bv[tt]; float o[4];
#pragma unroll
            for (int j = 0; j < 4; ++j) { const int s = 16 * mt + 4 * fq + j; o[j] = (s <= tt) ? a2[j] * __expf(btt - bv[s]) : 0.f; }
            u32x2 w; w.x = pk2(o[0], o[1]); w.y = pk2(o[2], o[3]);
            *(u32x2*)(aF + fo_off(tt, 16 * mt + 4 * fq, 2)) = w;
        }
    }
    __syncthreads();
    if (wave == 0) {
        float Tc[64];
#pragma unroll
        for (int i = 0; i < 64; ++i) Tc[i] = 0.f;
#pragma unroll
        for (int tt = 1; tt < 64; ++tt) {
            float s0 = -Af[tt * 68 + lane], s1 = 0.f, s2 = 0.f, s3 = 0.f;
#pragma unroll
            for (int s4 = 0; s4 < (tt + 3) / 4; ++s4) {
                const f32x4 av = *(const LAS f32x4*)(Af + tt * 68 + 4 * s4);
                s0 -= av.x * Tc[4 * s4]; s1 -= av.y * Tc[4 * s4 + 1]; s2 -= av.z * Tc[4 * s4 + 2]; s3 -= av.w * Tc[4 * s4 + 3];
            }
            Tc[tt] = (s0 + s1) + (s2 + s3);
        }
#pragma unroll
        for (int tt = 0; tt < 64; ++tt) Tm[tt * 72 + lane] = f2bf(Tc[tt]);
        LDS_WAIT();
        Tm[lane * 72 + lane] = (bf16_t)0x3F80;
    }
    __syncthreads();
#pragma unroll
    for (int mt = 0; mt < 4; ++mt) {
        f32x4 a = {0.f, 0.f, 0.f, 0.f};
#pragma unroll
        for (int k2 = 0; k2 < 2; ++k2) a = mfma16(*(const LAS bf16x8*)(Tm + (16 * mt + fr) * 72 + 32 * k2 + 8 * fq), *(const LAS bf16x8*)(VBT + (16 * wave + fr) * 72 + 32 * k2 + 8 * fq), a);
        u32x2 w; w.x = pk2(a[0], a[1]); w.y = pk2(a[2], a[3]);
        *(u32x2*)(uT + ((wave * 4 + mt) * 64 + lane) * 4) = w;
    }
#pragma unroll
    for (int nt = 0; nt < 4; ++nt) {
        f32x4 a = {0.f, 0.f, 0.f, 0.f};
#pragma unroll
        for (int k2 = 0; k2 < 2; ++k2) a = mfma16(*(const LAS bf16x8*)(KBT + (16 * wave + fr) * 72 + 32 * k2 + 8 * fq), *(const LAS bf16x8*)(Tm + (16 * nt + fr) * 72 + 32 * k2 + 8 * fq), a);
        u32x2 w; w.x = pk2(a[0], a[1]); w.y = pk2(a[2], a[3]);
        *(u32x2*)(wF + fo_off(16 * nt + fr, 16 * wave + 4 * fq, 4)) = w;
    }
    __syncthreads();
}

__device__ __forceinline__ void e2_hgrn(const Params& p, LAS unsigned char* lds, int item) {
    int tid_ = threadIdx.x; asm volatile("" : "+v"(tid_));
    { unsigned lb_ = (unsigned)(size_t)lds; asm volatile("" : "+v"(lb_)); lds = (LAS unsigned char*)(size_t)lb_; }
    const int tid = tid_, lane = tid & 63, wave = tid >> 6, fr = lane & 15, fq = lane >> 4;
    const int seq = item >> 5, n = item & 31, b = seq >> 2, h = seq & 3;
    const int t = tid >> 3, sub = tid & 7, c0 = sub * 16;
    const size_t r = (size_t)b * TP + n * 64 + t;
    LAS float* Bf = (LAS float*)lds; LAS bf16_t* Qm = (LAS bf16_t*)(lds + 33792); LAS bf16_t* Km = (LAS bf16_t*)(lds + 51200);
    const bf16_t* P16 = (const bf16_t*)(p.ws + WS_P16); const float* LOGG = (const float*)(p.ws + WS_LOGG);
    unsigned char* blk = p.ws + WS_E2H + (size_t)item * E2H_BYTES;
    bf16_t* qF = (bf16_t*)blk; bf16_t* kF = (bf16_t*)(blk + 16384); bf16_t* vF = (bf16_t*)(blk + 32768); bf16_t* aF = (bf16_t*)(blk + 49152); float* ebl = (float*)(blk + 57344);
    {
        const float* lp = LOGG + r * 512 + h * 128 + c0;
#pragma unroll
        for (int i = 0; i < 4; ++i) *(LAS f32x4*)(Bf + t * 132 + c0 + 4 * i) = *(const f32x4*)(lp + 4 * i);
    }
    __syncthreads();
    if (tid < 128) { float run = 0.f; for (int i = 0; i < 64; ++i) { run += Bf[i * 132 + tid]; Bf[i * 132 + tid] = run; } }
    __syncthreads();
    {
        float q[16], k[16]; const bf16_t* pr = P16 + r * 4096 + h * 128 + c0;
        unpack8(*(const u32x4*)pr, q); unpack8(*(const u32x4*)(pr + 8), q + 8);
        unpack8(*(const u32x4*)(pr + 512), k); unpack8(*(const u32x4*)(pr + 520), k + 8);
        const u32x4 v0 = *(const u32x4*)(pr + 1024), v1 = *(const u32x4*)(pr + 1032);
        const unsigned vw[8] = {v0.x, v0.y, v0.z, v0.w, v1.x, v1.y, v1.z, v1.w};
        float tq[16], tqm[16], tkm[16];
#pragma unroll
        for (int i = 0; i < 16; ++i) {
            const float bt = Bf[t * 132 + c0 + i], bl = Bf[63 * 132 + c0 + i], bm = Bf[31 * 132 + c0 + i];
            tq[i] = q[i] * __expf(bt); tqm[i] = q[i] * __expf(bt - bm); tkm[i] = k[i] * __expf(bm - bt);
            kF[fo_off(c0 + i, t, 2)] = f2bf(k[i] * __expf(bl - bt));
            vF[fo_off(c0 + i, t, 2)] = (bf16_t)((i & 1) ? (vw[i >> 1] >> 16) : (vw[i >> 1] & 0xffffu));
            if (t == 0) ebl[c0 + i] = __expf(bl);
        }
        *(u32x4*)(qF + fo_off(t, c0, 4)) = pack8(tq); *(u32x4*)(qF + fo_off(t, c0 + 8, 4)) = pack8(tq + 8);
        *(LAS u32x4*)(Qm + t * 136 + c0) = pack8(tqm); *(LAS u32x4*)(Qm + t * 136 + c0 + 8) = pack8(tqm + 8);
        *(LAS u32x4*)(Km + t * 136 + c0) = pack8(tkm); *(LAS u32x4*)(Km + t * 136 + c0 + 8) = pack8(tkm + 8);
    }
    __syncthreads();
#pragma unroll
    for (int q2 = 0; q2 < 2; ++q2) {
        const int id = 2 * wave + q2, mt = id >> 2, nt = id & 3;
        f32x4 a = {0.f, 0.f, 0.f, 0.f};
#pragma unroll
        for (int ks4 = 0; ks4 < 4; ++ks4) a = mfma16(*(const LAS bf16x8*)(Km + (16 * mt + fr) * 136 + 32 * ks4 + 8 * fq), *(const LAS bf16x8*)(Qm + (16 * nt + fr) * 136 + 32 * ks4 + 8 * fq), a);
        const int tt = 16 * nt + fr; float o[4];
#pragma unroll
        for (int j = 0; j < 4; ++j) { const int s = 16 * mt + 4 * fq + j; o[j] = (s <= tt) ? a[j] : 0.f; }
        u32x2 w; w.x = pk2(o[0], o[1]); w.y = pk2(o[2], o[3]);
        *(u32x2*)(aF + fo_off(tt, 16 * mt + 4 * fq, 2)) = w;
    }
    __syncthreads();
}

template <bool GDN>
__device__ __forceinline__ void e3_prompt(const Params& p, LAS unsigned char* lds, int e, int seq) {
    int tid_ = threadIdx.x; asm volatile("" : "+v"(tid_));
    { unsigned lb_ = (unsigned)(size_t)lds; asm volatile("" : "+v"(lb_)); lds = (LAS unsigned char*)(size_t)lb_; }
    const int tid = tid_, lane = tid & 63, wave = tid >> 6, fr = lane & 15, fq = lane >> 4;
    const int b = seq >> 2, h = seq & 3, v0 = wave * 16;
    LAS bf16_t* SLw = (LAS bf16_t*)(lds) + wave * (16 * 136); LAS bf16_t* VTw = (LAS bf16_t*)(lds + 34816) + wave * (16 * 72);
    LAS float* OT = (LAS float*)(lds + 53248);
    LAS float* EBw = (LAS float*)(lds + 120832) + wave * 128;
    const bf16_t* P16 = (const bf16_t*)(p.ws + WS_P16); bf16_t* OA = (bf16_t*)(p.ws + WS_OA);
    const float* nw = (GDN ? p.in[12] : p.in[8]) + e * 128;
    constexpr size_t IB = GDN ? E2G_BYTES : E2H_BYTES;
    constexpr int QF = GDN ? 32768 : 0, AF = GDN ? 65536 : 49152, KF = GDN ? 49152 : 16384;
    const unsigned char* base = p.ws + (GDN ? WS_E2G : WS_E2H) + (size_t)seq * 32 * IB;
    const int t = tid >> 3, sub = tid & 7, c0 = sub * 16;
    f32x4 S[8];
#pragma unroll
    for (int kt = 0; kt < 8; ++kt) S[kt] = (f32x4){0.f, 0.f, 0.f, 0.f};
    for (int n = 0; n < 32; ++n) {
        const unsigned char* blk = base + (size_t)n * IB;
        unsigned pf0 = 0u, pf1 = 0u;
        if (n + 1 < 32) { pf0 = *(const unsigned*)(blk + IB + (size_t)tid * 128); if ((size_t)65536 + (size_t)tid * 128 < IB) pf1 = *(const unsigned*)(blk + IB + 65536 + (size_t)tid * 128); }
        bf16x8 bS[4], bV[2], qA[16], aA[8], kA[16];
        LAS float* OTc = OT + (n & 1) * (64 * 132);
        if (GDN) {
            bf16x8 wA[16]; u32x2 uu[4];
#pragma unroll
            for (int i = 0; i < 16; ++i) wA[i] = *(const bf16x8*)((const bf16_t*)(blk + 16384) + (i * 64 + lane) * 8);
#pragma unroll
            for (int mt = 0; mt < 4; ++mt) uu[mt] = *(const u32x2*)((const bf16_t*)blk + ((wave * 4 + mt) * 64 + lane) * 4);
#pragma unroll
            for (int i = 0; i < 16; ++i) qA[i] = *(const bf16x8*)((const bf16_t*)(blk + QF) + (i * 64 + lane) * 8);
#pragma unroll
            for (int kt = 0; kt < 8; ++kt) { u32x2 w2; w2.x = pk2(S[kt].x, S[kt].y); w2.y = pk2(S[kt].z, S[kt].w); *(LAS u32x2*)(SLw + fr * 136 + 16 * kt + 4 * fq) = w2; }
#pragma unroll
            for (int ks = 0; ks < 4; ++ks) bS[ks] = *(const LAS bf16x8*)(SLw + fr * 136 + 32 * ks + 8 * fq);
            __builtin_amdgcn_sched_barrier(0);
#pragma unroll
            for (int mt = 0; mt < 4; ++mt) {
                f32x4 pa = {0.f, 0.f, 0.f, 0.f};
#pragma unroll
                for (int ks = 0; ks < 4; ++ks) pa = mfma16(wA[mt * 4 + ks], bS[ks], pa);
                u32x2 w2; w2.x = pk2(bflo(uu[mt].x) - pa.x, bfhi(uu[mt].x) - pa.y); w2.y = pk2(bflo(uu[mt].y) - pa.z, bfhi(uu[mt].y) - pa.w);
                *(LAS u32x2*)(VTw + fr * 72 + 16 * mt + 4 * fq) = w2;
            }
#pragma unroll
            for (int i = 0; i < 8; ++i) aA[i] = *(const bf16x8*)((const bf16_t*)(blk + AF) + (i * 64 + lane) * 8);
            const float d = *(const float*)(blk + 73728);
#pragma unroll
            for (int k2 = 0; k2 < 2; ++k2) bV[k2] = *(const LAS bf16x8*)(VTw + fr * 72 + 32 * k2 + 8 * fq);
            __builtin_amdgcn_sched_barrier(0);
            f32x4 acc[4];
#pragma unroll
            for (int mt = 0; mt < 4; ++mt) {
                acc[mt] = (f32x4){0.f, 0.f, 0.f, 0.f};
#pragma unroll
                for (int ks = 0; ks < 4; ++ks) acc[mt] = mfma16(qA[mt * 4 + ks], bS[ks], acc[mt]);
            }
#pragma unroll
            for (int i = 0; i < 16; ++i) kA[i] = *(const bf16x8*)((const bf16_t*)(blk + KF) + (i * 64 + lane) * 8);
            __builtin_amdgcn_sched_barrier(0);
#pragma unroll
            for (int mt = 0; mt < 4; ++mt) {
#pragma unroll
                for (int k2 = 0; k2 < 2; ++k2) acc[mt] = mfma16(aA[mt * 2 + k2], bV[k2], acc[mt]);
#pragma unroll
                for (int j = 0; j < 4; ++j) OTc[(16 * mt + 4 * fq + j) * 132 + v0 + fr] = acc[mt][j];
            }
#pragma unroll
            for (int kt = 0; kt < 8; ++kt) {
                S[kt] = S[kt] * d;
#pragma unroll
                for (int k2 = 0; k2 < 2; ++k2) S[kt] = mfma16(kA[kt * 2 + k2], bV[k2], S[kt]);
            }
        } else {
#pragma unroll
            for (int i = 0; i < 16; ++i) qA[i] = *(const bf16x8*)((const bf16_t*)(blk + QF) + (i * 64 + lane) * 8);
#pragma unroll
            for (int i = 0; i < 8; ++i) aA[i] = *(const bf16x8*)((const bf16_t*)(blk + AF) + (i * 64 + lane) * 8);
#pragma unroll
            for (int k2 = 0; k2 < 2; ++k2) bV[k2] = *(const bf16x8*)((const bf16_t*)(blk + 32768) + ((wave * 2 + k2) * 64 + lane) * 8);
            const f32x4 ev = *(const f32x4*)((const float*)(blk + 57344) + 4 * (lane & 31));
#pragma unroll
            for (int kt = 0; kt < 8; ++kt) { u32x2 w2; w2.x = pk2(S[kt].x, S[kt].y); w2.y = pk2(S[kt].z, S[kt].w); *(LAS u32x2*)(SLw + fr * 136 + 16 * kt + 4 * fq) = w2; }
#pragma unroll
            for (int ks = 0; ks < 4; ++ks) bS[ks] = *(const LAS bf16x8*)(SLw + fr * 136 + 32 * ks + 8 * fq);
            __builtin_amdgcn_sched_barrier(0);
            f32x4 acc[4];
#pragma unroll
            for (int mt = 0; mt < 4; ++mt) {
                acc[mt] = (f32x4){0.f, 0.f, 0.f, 0.f};
#pragma unroll
                for (int ks = 0; ks < 4; ++ks) acc[mt] = mfma16(qA[mt * 4 + ks], bS[ks], acc[mt]);
            }
#pragma unroll
            for (int i = 0; i < 16; ++i) kA[i] = *(const bf16x8*)((const bf16_t*)(blk + KF) + (i * 64 + lane) * 8);
            if (lane < 32) *(LAS f32x4*)(EBw + 4 * lane) = ev;
            __builtin_amdgcn_sched_barrier(0);
#pragma unroll
            for (int mt = 0; mt < 4; ++mt) {
#pragma unroll
                for (int k2 = 0; k2 < 2; ++k2) acc[mt] = mfma16(aA[mt * 2 + k2], bV[k2], acc[mt]);
#pragma unroll
                for (int j = 0; j < 4; ++j) OTc[(16 * mt + 4 * fq + j) * 132 + v0 + fr] = acc[mt][j];
            }
#pragma unroll
            for (int kt = 0; kt < 8; ++kt) {
                S[kt] = S[kt] * *(const LAS f32x4*)(EBw + 16 * kt + 4 * fq);
#pragma unroll
                for (int k2 = 0; k2 < 2; ++k2) S[kt] = mfma16(kA[kt * 2 + k2], bV[k2], S[kt]);
            }
        }
        asm volatile("" :: "v"(pf0), "v"(pf1));
        __syncthreads();
        {
            const size_t r = (size_t)b * TP + n * 64 + t;
            const bf16_t* gp = P16 + r * 4096 + (GDN ? 3584 : 1536) + h * 128 + c0;
            const u32x4 g0 = *(const u32x4*)gp, g1 = *(const u32x4*)(gp + 8);
            float o[16]; float sq = 0.f;
#pragma unroll
            for (int i = 0; i < 4; ++i) { const f32x4 v = *(const LAS f32x4*)(OTc + t * 132 + c0 + 4 * i); o[4 * i] = v.x; o[4 * i + 1] = v.y; o[4 * i + 2] = v.z; o[4 * i + 3] = v.w; sq += (v.x * v.x + v.y * v.y) + (v.z * v.z + v.w * v.w); }
            sq += __shfl_xor(sq, 1); sq += __shfl_xor(sq, 2); sq += __shfl_xor(sq, 4);
            const float rstd = rsqrtf(sq * (1.f / 128.f) + EPS);
            float gt[16]; unpack8(g0, gt); unpack8(g1, gt + 8);
#pragma unroll
            for (int i = 0; i < 16; ++i) { const float gate = GDN ? silu(gt[i]) : sigm(gt[i]); o[i] = o[i] * rstd * nw[c0 + i] * gate; }
            bf16_t* op = OA + r * D + (GDN ? 512 : 0) + h * 128 + c0;
            *(u32x4*)op = pack8(o); *(u32x4*)(op + 8) = pack8(o + 8);
        }
    }
    float* so = p.out + (GDN ? O_GDP : O_HGP) + ((size_t)(e * NB + b) * 4 + h) * 16384;
#pragma unroll
    for (int kt = 0; kt < 8; ++kt)
#pragma unroll
        for (int j = 0; j < 4; ++j) so[(16 * kt + 4 * fq + j) * 128 + v0 + fr] = S[kt][j];
    __syncthreads();
}

__device__ __forceinline__ void e3_sample(const Params& p, LAS unsigned char* lds, int e, int mx, int bh) {
    int tid_ = threadIdx.x; asm volatile("" : "+v"(tid_));
    { unsigned lb_ = (unsigned)(size_t)lds; asm volatile("" : "+v"(lb_)); lds = (LAS unsigned char*)(size_t)lb_; }
    const int tid = tid_, lane = tid & 63, wave = tid >> 6;
    const int b = bh >> 2, h = bh & 3; const size_t r = (size_t)MP + b;
    const bool gdn = (mx == 1);
    LAS float* qs = (LAS float*)lds; LAS float* ks = qs + 128; LAS float* gs = qs + 256; LAS float* vs = qs + 384; LAS float* vn = qs + 512; LAS float* misc = qs + 640; LAS float* red = qs + 1024;
    const bf16_t* P16 = (const bf16_t*)(p.ws + WS_P16); bf16_t* OA = (bf16_t*)(p.ws + WS_OA);
    float eg = 1.f, beta = 0.f;
    if (tid < 128) {
        const int c = tid;
        if (!gdn) {
            const bf16_t* pr = P16 + r * 4096 + h * 128 + c;
            qs[c] = bf2f(pr[0]); ks[c] = bf2f(pr[512]); vs[c] = bf2f(pr[1024]);
            gs[c] = __expf(((const float*)(p.ws + WS_LOGG))[r * 512 + h * 128 + c]);
        } else {
            const float* cw = p.in[9] + (size_t)e * 4 * 1536; const float* cb = p.in[4] + (size_t)(e * MS + b) * 3 * 1536;
            float* cso = p.out + O_CVS + (size_t)(e * MS + b) * 3 * 1536; float val[3];
#pragma unroll
            for (int part = 0; part < 3; ++part) {
                const int ch = part * 512 + h * 128 + c; const float x3 = bf2f(P16[r * 4096 + 2048 + ch]);
                const float b0 = cb[ch], b1 = cb[1536 + ch], b2 = cb[3072 + ch];
                val[part] = silu(b0 * cw[ch] + b1 * cw[1536 + ch] + b2 * cw[3072 + ch] + x3 * cw[4608 + ch]);
                cso[ch] = b1; cso[1536 + ch] = b2; cso[3072 + ch] = x3;
            }
            float q2 = wave_sum(val[0] * val[0]), k2 = wave_sum(val[1] * val[1]);
            if (lane == 0) { misc[wave] = q2; misc[2 + wave] = k2; }
            qs[c] = val[0]; ks[c] = val[1]; vs[c] = val[2];
        }
    }
    __syncthreads();
    if (gdn) {
        const float qn = rsqrtf(misc[0] + misc[1] + EPS) * 0.08838834764831845f, kn = rsqrtf(misc[2] + misc[3] + EPS);
        const float* AB = (const float*)(p.ws + WS_AB);
        const float a = AB[r * 8 + h], bb = AB[r * 8 + 4 + h];
        const float Ah = __expf(p.in[10][e * 4 + h]); const float x = a + p.in[11][e * 4 + h];
        const float sp = x > 20.f ? x : log1pf(__expf(x));
        eg = __expf(-Ah * sp); beta = sigm(bb);
        __syncthreads();
        if (tid < 128) { qs[tid] *= qn; ks[tid] *= kn; }
        __syncthreads();
    }
    const int c4 = (tid & 31) * 4, rg = tid >> 5;
    const float* s0 = (gdn ? p.in[3] : p.in[2]) + ((size_t)(e * MS + b) * 4 + h) * 16384;
    float* so = p.out + (gdn ? O_GDS : O_HGS) + ((size_t)(e * MS + b) * 4 + h) * 16384;
    f32x4 Sv[8];
#pragma unroll
    for (int i = 0; i < 8; ++i) Sv[i] = *(const f32x4*)(s0 + (rg + 16 * i) * 128 + c4);
    f32x4 vv;
    if (gdn) {
        f32x4 pk = {0.f, 0.f, 0.f, 0.f};
#pragma unroll
        for (int i = 0; i < 8; ++i) pk = pk + Sv[i] * ks[rg + 16 * i];
        *(LAS f32x4*)(red + rg * 128 + c4) = pk;
        __syncthreads();
        if (tid < 128) { float s = 0.f;
#pragma unroll
            for (int i = 0; i < 16; ++i) s += red[i * 128 + tid];
            vn[tid] = beta * vs[tid] - beta * eg * s; }
        __syncthreads();
        vv = *(const LAS f32x4*)(vn + c4);
    } else vv = *(const LAS f32x4*)(vs + c4);
    f32x4 po = {0.f, 0.f, 0.f, 0.f};
#pragma unroll
    for (int i = 0; i < 8; ++i) {
        const int k = rg + 16 * i; const float dk = gdn ? eg : gs[k];
        const f32x4 sn = Sv[i] * dk + vv * ks[k];
        *(f32x4*)(so + k * 128 + c4) = sn;
        po = po + sn * qs[k];
    }
    __syncthreads();
    *(LAS f32x4*)(red + rg * 128 + c4) = po;
    __syncthreads();
    float o = 0.f;
    if (tid < 128) {
#pragma unroll
        for (int i = 0; i < 16; ++i) o += red[i * 128 + tid];
        const float s2 = wave_sum(o * o); if (lane == 0) misc[4 + wave] = s2;
    }
    __syncthreads();
    if (tid < 128) {
        const float rstd = rsqrtf((misc[4] + misc[5]) * (1.f / 128.f) + EPS);
        const float gr = bf2f(P16[r * 4096 + (gdn ? 3584 : 1536) + h * 128 + tid]);
        const float gate = gdn ? silu(gr) : sigm(gr);
        const float nwv = (gdn ? p.in[12] : p.in[8])[e * 128 + tid];
        OA[r * D + (gdn ? 512 : 0) + h * 128 + tid] = f2bf(o * rstd * nwv * gate);
    }
    __syncthreads();
}

__device__ __forceinline__ void phase_pool(const Params& p, int o) {
    const bf16_t* U = (const bf16_t*)(p.ws + WS_P16); bf16_t* Dp = (bf16_t*)(p.ws + WS_P16 + (size_t)M * 1024 * 2);
    int tid_ = threadIdx.x; asm volatile("" : "+v"(tid_));
    const int gt = blockIdx.x * 512 + tid_, NGT = gridDim.x * 512;
    for (int idx = gt; idx < MR * 128; idx += NGT) {
        const int r = idx >> 7, c = (idx & 127) * 8, w = 2 << (c >> 8);
        float u[8], s[8]; unpack8(*(const u32x4*)(U + (size_t)r * D + c), u);
#pragma unroll
        for (int i = 0; i < 8; ++i) s[i] = u[i];
        float cnt;
        if (r < MP) {
            const int t = r & (TP - 1), b = r >> 11; cnt = (float)((t + 1 < w) ? t + 1 : w);
            const int lim = (w - 1 < t) ? w - 1 : t;
            u32x4 xr[15];
#pragma unroll
            for (int i = 1; i < 16; ++i) xr[i - 1] = *(const u32x4*)(U + (size_t)(r - ((i <= lim) ? i : 0)) * D + c);
#pragma unroll
            for (int i = 1; i < 16; ++i) { float x[8]; unpack8(xr[i - 1], x); const float m = (i <= lim) ? 1.f : 0.f;
#pragma unroll
                for (int q = 0; q < 8; ++q) s[q] += m * x[q]; }
            if (t >= TP - 15) { float* op = p.out + O_PLP + ((size_t)(o * NB + b) * 15 + (t - (TP - 15))) * D + c;
                *(f32x4*)op = (f32x4){u[0], u[1], u[2], u[3]}; *(f32x4*)(op + 4) = (f32x4){u[4], u[5], u[6], u[7]}; }
        } else {
            const int b = r - MP; cnt = (float)w;
            const float* buf = p.in[5] + (size_t)(o * MS + b) * 15 * D + c;
#pragma unroll
            for (int i = 1; i < 16; ++i) { if (i < w) { const f32x4 x0 = *(const f32x4*)(buf + (15 - i) * D), x1 = *(const f32x4*)(buf + (15 - i) * D + 4);
                s[0] += x0.x; s[1] += x0.y; s[2] += x0.z; s[3] += x0.w; s[4] += x1.x; s[5] += x1.y; s[6] += x1.z; s[7] += x1.w; } }
            float* op = p.out + O_PLS + (size_t)(o * MS + b) * 15 * D + c;
#pragma unroll
            for (int j = 0; j < 14; ++j) { *(f32x4*)(op + j * D) = *(const f32x4*)(buf + (j + 1) * D); *(f32x4*)(op + j * D + 4) = *(const f32x4*)(buf + (j + 1) * D + 4); }
            *(f32x4*)(op + 14 * D) = (f32x4){u[0], u[1], u[2], u[3]}; *(f32x4*)(op + 14 * D + 4) = (f32x4){u[4], u[5], u[6], u[7]};
        }
        const float ic = 1.f / cnt; float d[8];
#pragma unroll
        for (int i = 0; i < 8; ++i) d[i] = s[i] * ic - u[i];
        *(u32x4*)(Dp + (size_t)r * D + c) = pack8(d);
    }
}

__device__ __forceinline__ void phase_final(const Params& p) {
    int tid_ = threadIdx.x; asm volatile("" : "+v"(tid_));
    const int tid = tid_, lane = tid & 63, wave = tid >> 6;
    const int gw = blockIdx.x * 8 + wave, NGW = gridDim.x * 8;
    const u64* ss = (const u64*)(p.ws + WS_SS) + (size_t)12 * M; const float* fw = p.in[26];
    f32x4 wv[4];
#pragma unroll
    for (int j = 0; j < 4; ++j) wv[j] = *(const f32x4*)(fw + 4 * lane + 256 * j);
    for (int r = gw; r < MR; r += 2 * NGW) {
        const int r2 = r + NGW; const bool has2 = r2 < MR; const int rb = has2 ? r2 : r;
        const u64 s1 = ss[r], s2 = ss[rb];
        float* xp = p.out + (size_t)r * D; float* xq = p.out + (size_t)rb * D;
        f32x4 a[4], b[4];
#pragma unroll
        for (int j = 0; j < 4; ++j) { const int c = 4 * lane + 256 * j; a[j] = *(const f32x4*)(xp + c); b[j] = *(const f32x4*)(xq + c); }
        const float rs1 = SS_RS(s1), rs2 = SS_RS(s2);
#pragma unroll
        for (int j = 0; j < 4; ++j) { const int c = 4 * lane + 256 * j; *(f32x4*)(xp + c) = a[j] * wv[j] * rs1; }
        if (has2) {
#pragma unroll
            for (int j = 0; j < 4; ++j) { const int c = 4 * lane + 256 * j; *(f32x4*)(xq + c) = b[j] * wv[j] * rs2; }
        }
    }
}

#define XB_TMO      128
#define XB_XCNT(j)  (256  + 64 * (j))
#define XB_XSUB(j)  (1280 + 64 * (j))
#define XB_XGEN(j)  (2304 + 64 * (j))
#define XB_TOP      3328
#define XB_TOPGEN   3392
#define XCD_BAR_WORDS 3456
#define TS_OFF (WS_END + 16384)
#define XB_SPIN_CAP (1u << 22)
__device__ __forceinline__ unsigned xb_ld(unsigned* p) { return __hip_atomic_load(p, __ATOMIC_RELAXED, __HIP_MEMORY_SCOPE_AGENT); }
__device__ __forceinline__ unsigned xb_add(unsigned* p, unsigned v) { return __hip_atomic_fetch_add(p, v, __ATOMIC_RELAXED, __HIP_MEMORY_SCOPE_AGENT); }
__device__ __forceinline__ unsigned xb_xcc_id() { return (unsigned)__builtin_amdgcn_s_getreg((3 << 11) | 20) & 0xFu; }
#define XB_SPIN(cond, bar) do { unsigned _sp = 0; while (cond) { __builtin_amdgcn_s_sleep(1); \
    if ((++_sp & 255u) == 0u) { if (xb_ld(&(bar)[XB_TMO])) break; if (_sp > XB_SPIN_CAP) { atomicAdd(&(bar)[XB_TMO], 1u); break; } } } } while (0)
struct XcdBarrier { unsigned* bar; unsigned x; volatile LAS unsigned* st; };
__device__ __forceinline__ XcdBarrier xcd_barrier_post(unsigned* bar, volatile LAS unsigned* st) {
    XcdBarrier b; b.bar = bar; b.x = xb_xcc_id(); b.st = st;
    if (threadIdx.x == 0) (void)xb_add(&bar[XB_XCNT(b.x)], 1u);
    return b;
}
__device__ __forceinline__ void xcd_barrier_complete(unsigned* bar, unsigned x, unsigned& nloc, unsigned& nx) {
    const unsigned G = gridDim.x * gridDim.y * gridDim.z;
    unsigned sum, cnt, mine, sp = 0u;
    for (;;) {
        sum = 0u; cnt = 0u; mine = 0u;
#pragma unroll
        for (unsigned j = 0; j < 16; ++j) { const unsigned c = xb_ld(&bar[XB_XCNT(j)]); sum += c; cnt += (c > 0u) ? 1u : 0u; mine = (j == x) ? c : mine; }
        if (sum == G) break;
        __builtin_amdgcn_s_sleep(1);
        if ((++sp & 255u) == 0u) { if (xb_ld(&bar[XB_TMO])) break; if (sp > XB_SPIN_CAP) { atomicAdd(&bar[XB_TMO], 1u); break; } }
    }
    nloc = mine > 0u ? mine : 1u; nx = cnt > 0u ? cnt : 1u;
}
__device__ __forceinline__ void xcd_barrier(const XcdBarrier& b) {
    asm volatile("s_waitcnt vmcnt(0)" ::: "memory");
    __syncthreads();
    if (threadIdx.x == 0) {
        unsigned* bar = b.bar;
        __builtin_amdgcn_s_waitcnt(0);
        unsigned nloc = b.st[0], nx = b.st[1];
        if (nloc == 0u) { xcd_barrier_complete(bar, b.x, nloc, nx); b.st[0] = nloc; b.st[1] = nx; }
        const unsigned old = xb_add(&bar[XB_XSUB(b.x)], 1u);
        const unsigned gen = old / nloc;
        if (old + 1u == (gen + 1u) * nloc) {
            __builtin_amdgcn_fence(__ATOMIC_RELEASE, "agent");
            asm volatile("s_waitcnt vmcnt(0)" ::: "memory");
            const unsigned og = xb_add(&bar[XB_TOP], 1u);
            const unsigned tg = og / nx;
            if (og + 1u == (tg + 1u) * nx) xb_add(&bar[XB_TOPGEN], 1u);
            else XB_SPIN(xb_ld(&bar[XB_TOPGEN]) == tg, bar);
            __builtin_amdgcn_fence(__ATOMIC_ACQUIRE, "agent");
            xb_add(&bar[XB_XGEN(b.x)], 1u);
            asm volatile("s_waitcnt vmcnt(0)" ::: "memory");
        } else {
            XB_SPIN(xb_ld(&bar[XB_XGEN(b.x)]) == gen, bar);
            __builtin_amdgcn_fence(__ATOMIC_ACQUIRE, "agent");
            asm volatile("s_waitcnt vmcnt(0)" ::: "memory");
        }
    }
    __syncthreads();
}

__global__ void __launch_bounds__(512) mega(Params p) {
    extern __shared__ __attribute__((aligned(16))) unsigned char shm[];
    LAS unsigned char* lds = (LAS unsigned char*)shm;
    cg::grid_group grid = cg::this_grid();
    unsigned char* ws = p.ws;
    volatile LAS unsigned* xst = (volatile LAS unsigned*)(lds + 131072);
    if (threadIdx.x == 0) { xst[0] = 0u; xst[1] = 0u; }
    __syncthreads();
    XcdBarrier xb = xcd_barrier_post((unsigned*)(ws + WS_END), xst);
    const int G = gridDim.x;
    u64* SS = (u64*)(ws + WS_SS);
    bf16_t* XB = (bf16_t*)(ws + WS_XB);
    __builtin_amdgcn_fence(__ATOMIC_ACQUIRE, "agent");
    for (int ph = p.ph_lo; ph < p.ph_hi; ++ph) {
        int kind, li = 0, half = 0;
        if (ph == 0) kind = 0;
        else if (ph == NPH - 1) kind = 10;
        else {
            int q = ph - 1;
            if (q < 8) li = 0; else if (q < 15) { li = 1; q -= 8; } else if (q < 23) { li = 2; q -= 15; } else { li = 3; q -= 23; }
            const bool even = !(li & 1);
            if (q == 0) { kind = 1; half = 0; } else if (q == 1) { kind = 2; half = 0; }
            else if (even) { if (q < 6) kind = q + 1; else { kind = q - 5; half = 1; } }
            else { if (q < 5) kind = q + 5; else { kind = q - 4; half = 1; } }
        }
        const int e = li >> 1, f = li * 2 + half;
        pg8::StaticOrder S;
        if (kind == 0) phase_prep(p, lds);
        else if (kind == 1) {
            pg8::Gemm g{XB, (const bf16_t*)(ws + WS_WGU + f * SZ_WGU), NMT, 22, 1024, 1024, 0, 1024, 22, 0};
            unsigned* cnt = (unsigned*)(ws + WS_END + 16384) + 31 * 128 + f;
            pg8::EpiGU E{(bf16_t*)(ws + WS_P16), SS + (size_t)(3 * li + (half ? 2 : 0)) * M, (G == 256) ? cnt : nullptr};
            if (G == 256) S.init_f1(blockIdx.x); else S.init(g.nM, g.nN, G, blockIdx.x);
            pg8::gemm_phase(lds, g, S, E);
            if (G == 256 && blockIdx.x >= 248) {
                if (threadIdx.x == 0) { unsigned sp = 0; while (xb_ld(cnt) < 22u * 8u) { __builtin_amdgcn_s_sleep(2); if (++sp > (1u << 24)) break; } }
                __syncthreads();
                __builtin_amdgcn_fence(__ATOMIC_ACQUIRE, "agent");
                asm volatile("s_waitcnt vmcnt(0)" ::: "memory");
                pg8::EpiX EX; EX.X = p.out; EX.XB = XB; EX.scale = nullptr; EX.alpha = 0.5f; EX.ssn = SS + (size_t)(3 * li + (half ? 3 : 1)) * M;
                pg8::Gemm gs{(const bf16_t*)(ws + WS_P16), (const bf16_t*)(ws + WS_WD + f * SZ_WD), 1, 8, 1408, 2816, 0, 2816, 4, 64};
                pg8::EpiSplitX ES{EX, (float*)(ws + WS_E2G), (unsigned*)(ws + WS_END + 16384) + ph * 128, 4};
                S.init(1, 8, 8, blockIdx.x - 248); pg8::gemm_phase(lds, gs, S, ES);
            }
        } else if ((kind == 2 || kind == 6 || kind == 9)) {
            pg8::Gemm g; pg8::EpiX E; E.X = p.out; E.XB = XB; E.scale = nullptr;
            int NS = 0;
            if (kind == 2) { g = pg8::Gemm{(const bf16_t*)(ws + WS_P16), (const bf16_t*)(ws + WS_WD + f * SZ_WD), 64, 4, 2816, 2816, 0, 2816, 4, 0}; E.alpha = 0.5f; E.ssn = SS + (size_t)(3 * li + (half ? 3 : 1)) * M; NS = 2; }
            else if (kind == 6) { g = pg8::Gemm{(const bf16_t*)(ws + WS_OA), (const bf16_t*)(ws + WS_WOUT + e * SZ_W1K), NMT, 4, 1024, 1024, 0, 1024, 4, 0}; E.alpha = 1.f; E.ssn = SS + (size_t)(3 * li + 2) * M; }
            else { g = pg8::Gemm{(const bf16_t*)(ws + WS_P16 + (size_t)M * 1024 * 2), (const bf16_t*)(ws + WS_WGRP + e * SZ_WGRP), NMT, 4, 256, 1024, 256, 256, 4, 0}; E.alpha = 1.f; E.ssn = SS + (size_t)(3 * li + 2) * M; E.scale = p.in[16] + e * D; }
            S.init(g.nM, g.nN, G, blockIdx.x); pg8::gemm_phase(lds, g, S, E);
            if (NS && G != 256) {
                pg8::Gemm gs = g; gs.nM = 1; gs.nN = 4 * NS; gs.K = g.K / NS; gs.pm0 = 64;
                pg8::EpiSplitX ES{E, (float*)(ws + WS_E2G), (unsigned*)(ws + WS_END + 16384) + ph * 128, 4};
                S.init(gs.nM, gs.nN, G, blockIdx.x); pg8::gemm_phase(lds, gs, S, ES);
            }
        } else if (kind == 3) {
            const u64* ss = SS + (size_t)(3 * li + 1) * M;
            pg8::Gemm g{XB, (const bf16_t*)(ws + WS_WIN + e * SZ_WIN), NMT, 16, 1024, 1024, 0, 1024, 16, 0};
            pg8::EpiP E{(bf16_t*)(ws + WS_P16), (float*)(ws + WS_LOGG), ss, p.in[6], e};
            S.init(g.nM, g.nN, G, blockIdx.x); pg8::gemm_phase(lds, g, S, E);
            phase_ab(p, e, ss);
        } else if (kind == 4) {
            for (int it = blockIdx.x, k = 0; it < 2048; it += G, ++k) { if ((it + k) & 1) e2_gdn(p, lds, e, it >> 1); else e2_hgrn(p, lds, it >> 1); }
        } else if (kind == 5) {
            if (G > 64) {
                if (blockIdx.x < 64) { if (blockIdx.x & 1) e3_prompt<true>(p, lds, e, blockIdx.x >> 1); else e3_prompt<false>(p, lds, e, blockIdx.x >> 1); }
                else {
                    for (int s = blockIdx.x - 64; s < 1024; s += G - 64) e3_sample(p, lds, e, s & 1, s >> 1);
                    __syncthreads();
                    int tid2 = threadIdx.x; asm volatile("" : "+v"(tid2));
                    LAS float* scr = (LAS float*)(lds + (tid2 >> 6) * 8448);
                    const int worker = (blockIdx.x - 64) * 8 + (tid2 >> 6), nworkers = (G - 64) * 8;
                    if (li == 0) { convert_layer(p, scr, 1, worker, nworkers, tid2 & 63); convert_layer(p, scr, 2, worker, nworkers, tid2 & 63); }
                    else convert_layer(p, scr, 3, worker, nworkers, tid2 & 63);
                    __syncthreads();
                }
            } else {
                for (int it = blockIdx.x; it < 64; it += G) { if (it & 1) e3_prompt<true>(p, lds, e, it >> 1); else e3_prompt<false>(p, lds, e, it >> 1); }
                for (int s = blockIdx.x; s < 1024; s += G) e3_sample(p, lds, e, s & 1, s >> 1);
            }
        } else if (kind == 7) {
            pg8::Gemm g{XB, (const bf16_t*)(ws + WS_WP + e * SZ_W1K), NMT, 4, 1024, 1024, 0, 1024, 4, 0};
            pg8::EpiU E{(bf16_t*)(ws + WS_P16), SS + (size_t)(3 * li + 1) * M};
            S.init(g.nM, g.nN, G, blockIdx.x); pg8::gemm_phase(lds, g, S, E);
        } else if (kind == 8) phase_pool(p, e);
        else if (kind == 10) phase_final(p);
        if (ph + 1 < p.ph_hi) { if (p.ph_lo < 0) grid.sync(); else xcd_barrier(xb); }
    }
    __builtin_amdgcn_fence(__ATOMIC_RELEASE, "agent");
}

extern "C" void kernel_launch(void* const* d_in, const int* in_sizes, int n_in, void* d_out, int out_size, void* d_ws, size_t ws_size, hipStream_t stream) {
    static int grid = 0;
    if (grid == 0) {
        if (n_in != 27 || ws_size < WS_END + 32768) { fprintf(stderr, "kernel_launch: unexpected inputs (n_in %d, ws %zu, need %zu)\n", n_in, ws_size, (size_t)WS_END + 32768); grid = -1; return; }
        int dev = 0, cus = 0, per_cu = 0;
        (void)hipGetDevice(&dev); (void)hipDeviceGetAttribute(&cus, hipDeviceAttributeMultiprocessorCount, dev);
        (void)hipFuncSetAttribute((const void*)mega, hipFuncAttributeMaxDynamicSharedMemorySize, LDS_BYTES);
        (void)hipOccupancyMaxActiveBlocksPerMultiprocessor(&per_cu, (const void*)mega, 512, LDS_BYTES);
        (void)hipGetLastError();
        grid = cus;
    }
    if (grid < 0) return;
    Params p{};
    for (int i = 0; i < 27; ++i) p.in[i] = (const float*)d_in[i];
    p.out = (float*)d_out; p.ws = (unsigned char*)d_ws;
    (void)hipMemsetAsync((char*)d_ws + WS_END, 0, 32768, stream);
    p.ph_lo = 0; p.ph_hi = NPH;
    void* args[] = {&p};
    hipError_t e = hipLaunchCooperativeKernel((const void*)mega, dim3(grid), dim3(512), args, LDS_BYTES, stream);
    if (e != hipSuccess) fprintf(stderr, "cooperative launch failed: %s\n", hipGetErrorString(e));
}
```
